# Optimizing an MI355X kernel written in HIP

```python
import math
import jax, jax.numpy as jnp
from jax import lax
import numpy as np

D_MODEL = 1024
BATCH = 2
SEQ = 8192
DEPTH = 4

N_A_LAYERS = DEPTH // 2
N_B_LAYERS = DEPTH - N_A_LAYERS
D_RNN = D_MODEL
LRU_HEADS = 4
LRU_BLOCK = D_RNN // LRU_HEADS
CONV_WIDTH = 4
LRU_C = 8.0
MLA_HEADS = 16
QK_NOPE = 64
QK_ROPE = 32
V_HEAD = 64
Q_LORA = 384
KV_LORA = 256
ROPE_THETA = 10000.0
Q_BLOCK = 128
ATTN_SCALE = 1.0 / math.sqrt(QK_NOPE + QK_ROPE)
PEER_HEADS = 8
N_KEYS = 128
N_EXPERTS = N_KEYS * N_KEYS
PEER_TOPK = 16
PEER_QDIM = 256
PEER_HALF = PEER_QDIM // 2
PEER_CHUNK = 128
RMS_EPS = 1e-6
NEG_INF = -1e30

kernel_name = 'yoco_hawk_mla_peer'


def rmsnorm(x, g):
    xf = x.astype(jnp.float32)
    y = xf * lax.rsqrt(jnp.mean(xf * xf, axis=-1, keepdims=True) + RMS_EPS)
    return (y * g.astype(jnp.float32)).astype(x.dtype)


def rope(x, positions):
    half = QK_ROPE // 2
    freqs = ROPE_THETA ** (-jnp.arange(half, dtype=jnp.float32) / half)
    ang = positions.astype(jnp.float32)[..., None] * freqs
    ang = ang.reshape(ang.shape[:2] + (1,) * (x.ndim - 3) + (half,))
    cos, sin = jnp.cos(ang), jnp.sin(ang)
    xf = x.astype(jnp.float32)
    x1, x2 = xf[..., :half], xf[..., half:]
    out = jnp.concatenate([x1 * cos - x2 * sin, x1 * sin + x2 * cos], axis=-1)
    return out.astype(x.dtype)


def _lru_combine(left, right):
    a1, b1 = left
    a2, b2 = right
    return a1 * a2, a2 * b1 + b2


def rglru_block(h, w_in, conv_w, conv_b, wa, ba, wx, bx, lam, w_out):
    B, S, _ = h.shape
    gate_in, rec_in = jnp.split(h @ w_in, 2, axis=-1)
    gate = jax.nn.gelu(gate_in, approximate=False)
    xp = jnp.pad(rec_in, ((0, 0), (CONV_WIDTH - 1, 0), (0, 0)))
    xc = conv_b
    for k in range(CONV_WIDTH):
        xc = xc + xp[:, k:k + S] * conv_w[k]
    xb = xc.reshape(B, S, LRU_HEADS, LRU_BLOCK)
    r = jax.nn.sigmoid(jnp.einsum('bshi,hij->bshj', xb, wa).reshape(B, S, D_RNN) + ba)
    i = jax.nn.sigmoid(jnp.einsum('bshi,hij->bshj', xb, wx).reshape(B, S, D_RNN) + bx)
    log_a = -LRU_C * r.astype(jnp.float32) * jax.nn.softplus(-lam.astype(jnp.float32))
    a = jnp.exp(log_a)
    b = jnp.sqrt(-jnp.expm1(2.0 * log_a)) * (i * xc).astype(jnp.float32)
    _, hs = lax.associative_scan(_lru_combine, (a, b), axis=1)
    return (gate * hs.astype(h.dtype)) @ w_out


def shared_kv(x, c, kv_ada_w, kv_ada_b, kv_norm_g, w_dkv, w_kr, kv_latent_g, w_uk, w_uv, positions):
    B, S, _ = x.shape
    shift, scale = jnp.split((jax.nn.silu(c) @ kv_ada_w + kv_ada_b)[:, None, :], 2, axis=-1)
    h = rmsnorm(x, kv_norm_g) * (1.0 + scale) + shift
    c_kv = rmsnorm(h @ w_dkv, kv_latent_g)
    k_rope = rope(h @ w_kr, positions)
    k_nope = (c_kv @ w_uk).reshape(B, S, MLA_HEADS, QK_NOPE)
    v = (c_kv @ w_uv).reshape(B, S, MLA_HEADS, V_HEAD)
    return k_nope, k_rope, v


def _to_blocks(t, block):
    B, S = t.shape[:2]
    return jnp.moveaxis(t.reshape((B, S // block, block) + t.shape[2:]), 1, 0)


def _from_blocks(t):
    nb, B, blk = t.shape[:3]
    return jnp.moveaxis(t, 0, 1).reshape((B, nb * blk) + t.shape[3:])


def mla_block(h, w_dq, q_latent_g, w_uq, w_o, k_nope, k_rope, v, positions):
    B, S, _ = h.shape
    q_lat = rmsnorm(h @ w_dq, q_latent_g)
    q = (q_lat @ w_uq).reshape(B, S, MLA_HEADS, QK_NOPE + QK_ROPE)
    q_nope = q[..., :QK_NOPE]
    q_rope = rope(q[..., QK_NOPE:], positions)

    def attend(args):
        qn, qr, qpos = args
        s = (jnp.einsum('bqhd,bkhd->bhqk', qn, k_nope)
             + jnp.einsum('bqhr,bkr->bhqk', qr, k_rope)).astype(jnp.float32) * ATTN_SCALE
        mask = positions[:, None, None, :] <= qpos[:, None, :, None]
        p = jax.nn.softmax(jnp.where(mask, s, NEG_INF), axis=-1).astype(v.dtype)
        return jnp.einsum('bhqk,bkhd->bqhd', p, v)

    out = lax.map(attend, (_to_blocks(q_nope, Q_BLOCK), _to_blocks(q_rope, Q_BLOCK),
                           _to_blocks(positions, Q_BLOCK)))
    out = _from_blocks(out).reshape(B, S, MLA_HEADS * V_HEAD)
    return out @ w_o


def peer(h, w_q, sub_keys, u_tab, v_tab):
    B, S, _ = h.shape
    q = (h @ w_q).reshape(B, S, PEER_HEADS, 2, PEER_HALF)
    s = jnp.einsum('bshpd,hpnd->bshpn', q, sub_keys).astype(jnp.float32)
    v1, i1 = lax.top_k(s[..., 0, :], PEER_TOPK)
    v2, i2 = lax.top_k(s[..., 1, :], PEER_TOPK)
    cand = (v1[..., :, None] + v2[..., None, :]).reshape(B, S, PEER_HEADS, PEER_TOPK * PEER_TOPK)
    cv, ci = lax.top_k(cand, PEER_TOPK)
    e1 = jnp.take_along_axis(i1, ci // PEER_TOPK, axis=-1)
    e2 = jnp.take_along_axis(i2, ci % PEER_TOPK, axis=-1)
    idx = e1 * N_KEYS + e2
    g = jax.nn.softmax(cv, axis=-1).astype(h.dtype)

    def experts(args):
        hc, ic, gc = args
        act = jax.nn.gelu(jnp.einsum('bcd,bchkd->bchk', hc, u_tab[ic]), approximate=False)
        return jnp.einsum('bchk,bchkd->bcd', gc * act, v_tab[ic])

    out = lax.map(experts, (_to_blocks(h, PEER_CHUNK), _to_blocks(idx, PEER_CHUNK),
                            _to_blocks(g, PEER_CHUNK)))
    return _from_blocks(out)


def _normal(key, shape, fan_in):
    return jax.random.normal(key, shape, jnp.float32) * (fan_in ** -0.5)


def _gain(key, shape):
    return 1.0 + 0.02 * jax.random.normal(key, shape, jnp.float32)


def _bias(key, shape):
    return 0.02 * jax.random.normal(key, shape, jnp.float32)


def setup_inputs(seed: int = 0) -> dict:
    key = jax.random.key(seed)
    ks = iter(jax.random.split(key, 40))
    D = D_MODEL
    x = jax.random.normal(next(ks), (BATCH, SEQ, D), jnp.float32)
    c = jax.random.normal(next(ks), (BATCH, D), jnp.float32)
    offset = jax.random.randint(next(ks), (BATCH, 1), 0, 1024, dtype=jnp.int32)
    positions = offset + jnp.arange(SEQ, dtype=jnp.int32)[None, :]
    u = jax.random.uniform(next(ks), (N_A_LAYERS, D_RNN), jnp.float32, 0.9, 0.999)
    a0 = u ** (1.0 / LRU_C)
    lru_lambda = jnp.log(a0) - jnp.log1p(-a0)
    return {
        'x': x, 'c': c, 'positions': positions,
        'ada_w': _normal(next(ks), (DEPTH, D, 6 * D), D),
        'ada_b': _bias(next(ks), (DEPTH, 6 * D)),
        'norm_mix_g': _gain(next(ks), (DEPTH, D)),
        'norm_ffn_g': _gain(next(ks), (DEPTH, D)),
        'lru_w_in': _normal(next(ks), (N_A_LAYERS, D, 2 * D_RNN), D),
        'lru_conv_w': _normal(next(ks), (N_A_LAYERS, CONV_WIDTH, D_RNN), CONV_WIDTH),
        'lru_conv_b': _bias(next(ks), (N_A_LAYERS, D_RNN)),
        'lru_wa': _normal(next(ks), (N_A_LAYERS, LRU_HEADS, LRU_BLOCK, LRU_BLOCK), LRU_BLOCK),
        'lru_ba': _bias(next(ks), (N_A_LAYERS, D_RNN)),
        'lru_wx': _normal(next(ks), (N_A_LAYERS, LRU_HEADS, LRU_BLOCK, LRU_BLOCK), LRU_BLOCK),
        'lru_bx': _bias(next(ks), (N_A_LAYERS, D_RNN)),
        'lru_lambda': lru_lambda,
        'lru_w_out': _normal(next(ks), (N_A_LAYERS, D_RNN, D), D_RNN),
        'kv_ada_w': _normal(next(ks), (D, 2 * D), D),
        'kv_ada_b': _bias(next(ks), (2 * D,)),
        'kv_norm_g': _gain(next(ks), (D,)),
        'mla_w_dkv': _normal(next(ks), (D, KV_LORA), D),
        'mla_w_kr': _normal(next(ks), (D, QK_ROPE), D),
        'mla_kv_latent_g': _gain(next(ks), (KV_LORA,)),
        'mla_w_uk': _normal(next(ks), (KV_LORA, MLA_HEADS * QK_NOPE), KV_LORA),
        'mla_w_uv': _normal(next(ks), (KV_LORA, MLA_HEADS * V_HEAD), KV_LORA),
        'mla_w_dq': _normal(next(ks), (N_B_LAYERS, D, Q_LORA), D),
        'mla_q_latent_g': _gain(next(ks), (N_B_LAYERS, Q_LORA)),
        'mla_w_uq': _normal(next(ks), (N_B_LAYERS, Q_LORA, MLA_HEADS * (QK_NOPE + QK_ROPE)), Q_LORA),
        'mla_w_o': _normal(next(ks), (N_B_LAYERS, MLA_HEADS * V_HEAD, D), MLA_HEADS * V_HEAD),
        'peer_w_q': _normal(next(ks), (DEPTH, D, PEER_HEADS * PEER_QDIM), D),
        'peer_sub_keys': _normal(next(ks), (DEPTH, PEER_HEADS, 2, N_KEYS, PEER_HALF), PEER_HALF),
        'peer_u': _normal(next(ks), (DEPTH, N_EXPERTS, D), D),
        'peer_v': _normal(next(ks), (DEPTH, N_EXPERTS, D), PEER_HEADS),
        'final_g': _gain(next(ks), (D,)),
    }


def reference(x, c, positions, ada_w, ada_b, norm_mix_g, norm_ffn_g,
              lru_w_in, lru_conv_w, lru_conv_b, lru_wa, lru_ba, lru_wx, lru_bx, lru_lambda, lru_w_out,
              kv_ada_w, kv_ada_b, kv_norm_g, mla_w_dkv, mla_w_kr, mla_kv_latent_g, mla_w_uk, mla_w_uv,
              mla_w_dq, mla_q_latent_g, mla_w_uq, mla_w_o,
              peer_w_q, peer_sub_keys, peer_u, peer_v, final_g):
    k_nope = k_rope = v = None
    for l in range(DEPTH):
        if l == N_A_LAYERS:
            k_nope, k_rope, v = shared_kv(x, c, kv_ada_w, kv_ada_b, kv_norm_g, mla_w_dkv, mla_w_kr,
                                          mla_kv_latent_g, mla_w_uk, mla_w_uv, positions)
        mod = (jax.nn.silu(c) @ ada_w[l] + ada_b[l])[:, None, :]
        sh1, sc1, g1, sh2, sc2, g2 = jnp.split(mod, 6, axis=-1)
        h = rmsnorm(x, norm_mix_g[l]) * (1.0 + sc1) + sh1
        if l < N_A_LAYERS:
            y = rglru_block(h, lru_w_in[l], lru_conv_w[l], lru_conv_b[l], lru_wa[l], lru_ba[l],
                            lru_wx[l], lru_bx[l], lru_lambda[l], lru_w_out[l])
        else:
            j = l - N_A_LAYERS
            y = mla_block(h, mla_w_dq[j], mla_q_latent_g[j], mla_w_uq[j], mla_w_o[j],
                          k_nope, k_rope, v, positions)
        x = x + g1 * y
        h = rmsnorm(x, norm_ffn_g[l]) * (1.0 + sc2) + sh2
        x = x + g2 * peer(h, peer_w_q[l], peer_sub_keys[l], peer_u[l], peer_v[l])
    return rmsnorm(x, final_g)
```

```cpp
#include <hip/hip_runtime.h>
#include <hip/hip_cooperative_groups.h>
#include <stdint.h>
#include <string.h>
#include <stdio.h>
namespace cg = cooperative_groups;

#ifndef MULTI
#define MULTI 0
#endif
#ifndef REPMASK
#define REPMASK 0x0
#endif
#ifndef SYNCX
#define SYNCX 0
#endif
#ifndef OPMASK
#define OPMASK 0xFFFF
#endif

#define DI __device__ __forceinline__
DI int TIDX() { int t = (int)__builtin_amdgcn_workitem_id_x(); asm volatile("" : "+v"(t)); return t; }
typedef unsigned short bf16_t;
typedef __attribute__((ext_vector_type(8))) short bf16x8;
typedef __attribute__((ext_vector_type(16))) float f32x16;
typedef unsigned u32x4 __attribute__((ext_vector_type(4)));
typedef __bf16 bf16x2_t __attribute__((ext_vector_type(2)));
typedef float f32x2_t __attribute__((ext_vector_type(2)));
typedef float f32x4_t __attribute__((ext_vector_type(4)));
typedef _Float16 half_t;
typedef _Float16 h16x2_t __attribute__((ext_vector_type(2)));
#define MFMA(a, b, c) __builtin_amdgcn_mfma_f32_32x32x16_bf16((a), (b), (c), 0, 0, 0)

constexpr int T = 16384, D = 1024, SEQ = 8192;
constexpr size_t MB = 1048576;
constexpr size_t OFF_X = 0, OFF_H = 64 * MB, OFF_SCR = 96 * MB, OFF_QP = 352 * MB, OFF_PIDX = 416 * MB, OFF_PG = 424 * MB,
                 OFF_MODS = 432 * MB, OFF_SUM = 433 * MB, OFF_BAR = 435 * MB, OFF_W = 436 * MB, OFF_TU = 480 * MB, OFF_TV = 544 * MB, OFF_SU = 608 * MB, OFF_SV = 609 * MB;
constexpr size_t SA_G = 0, SA_REC = 32 * MB, SA_XC = 64 * MB, SA_AA = 96 * MB, SA_BB = 160 * MB, SA_YG = 224 * MB;
constexpr size_t SB_KN = 0, SB_VT = 32 * MB, SB_KR = 64 * MB, SB_CKV = 65 * MB, SB_KVRAW = 73 * MB, SB_HKV = 97 * MB,
                 SB_QLRAW = 129 * MB, SB_QL = 153 * MB, SB_QM = 165 * MB, SB_AO = 213 * MB;
constexpr size_t W_WIN = 0, W_GATE = W_WIN + 2 * 2048 * 1024, W_WOUT = W_GATE + 2 * 2048 * 256, W_DKV = W_WOUT + 2 * 1024 * 1024,
                 W_UKV = W_DKV + 384 * 1024, W_DQ = W_UKV + 2048 * 256, W_UQ = W_DQ + 2 * 384 * 1024, W_WO = W_UQ + 2 * 1536 * 384,
                 W_PQ = W_WO + 2 * 1024 * 1024, W_KEYS = W_PQ + 4 * 2048 * 1024, W_END = W_KEYS + 4 * 262144;
static_assert(W_END * 2 <= 44 * MB, "weights overflow");

constexpr int NJOBS = 34;
struct TJob { const float* src; bf16_t* dst; int K, N, ldd, mode, rowbase, tile0, ntiles, pad; };
struct Params {
  const float *x, *c; const int* pos;
  const float *ada_w, *ada_b, *norm_mix_g, *norm_ffn_g;
  const float *lru_w_in, *lru_conv_w, *lru_conv_b, *lru_wa, *lru_ba, *lru_wx, *lru_bx, *lru_lambda, *lru_w_out;
  const float *kv_ada_w, *kv_ada_b, *kv_norm_g, *w_dkv, *w_kr, *kv_latent_g, *w_uk, *w_uv;
  const float *w_dq, *q_latent_g, *w_uq, *w_o;
  const float *peer_w_q, *peer_keys, *peer_u, *peer_v, *final_g;
  float* out; char* ws;
  TJob jobs[NJOBS];
  int n_tconv, pad0;
};

constexpr int SMEM_MAIN = 73728;
constexpr int SMEM_TOTAL = SMEM_MAIN + 2048;

__device__ const float ROPE_FREQ[16] = {1.0f, 0.5623413251903491f, 0.31622776601683794f, 0.1778279410038923f,
  0.1f, 0.05623413251903491f, 0.031622776601683794f, 0.01778279410038923f, 0.01f, 0.005623413251903491f,
  0.0031622776601683794f, 0.001778279410038923f, 0.001f, 0.0005623413251903491f, 0.00031622776601683794f, 0.0001778279410038923f};

DI unsigned pack2(float a, float b) {
  f32x2_t v = {a, b};
  bf16x2_t r = __builtin_convertvector(v, bf16x2_t);
  return __builtin_bit_cast(unsigned, r);
}
DI bf16_t f2bf(float a) { return (bf16_t)(pack2(a, 0.f) & 0xffffu); }
DI float bflo(unsigned u) { return __uint_as_float(u << 16); }
DI float bfhi(unsigned u) { return __uint_as_float(u & 0xffff0000u); }
DI float bf2f(bf16_t b) { return __uint_as_float(((unsigned)b) << 16); }
DI float hlo(unsigned u) { return (float)__builtin_bit_cast(h16x2_t, u).x; }
DI float hhi(unsigned u) { return (float)__builtin_bit_cast(h16x2_t, u).y; }
DI unsigned packh2(float a, float b) { h16x2_t v = {(half_t)a, (half_t)b}; return __builtin_bit_cast(unsigned, v); }
DI float dot2(unsigned a, unsigned b, float c) {
  return __builtin_amdgcn_fdot2_f32_bf16(__builtin_bit_cast(bf16x2_t, a), __builtin_bit_cast(bf16x2_t, b), c, false);
}
DI float wave_sum(float v) {
#pragma unroll
  for (int o = 32; o > 0; o >>= 1) v += __shfl_xor(v, o);
  return v;
}
DI float fast_erf(float x) {
  const float ax = fabsf(x);
  const float t = __builtin_amdgcn_rcpf(1.f + 0.3275911f * ax);
  const float poly = t * (0.254829592f + t * (-0.284496736f + t * (1.421413741f + t * (-1.453152027f + t * 1.061405429f))));
  const float e = 1.f - poly * __builtin_amdgcn_exp2f(-1.4426950408889634f * ax * ax);
  return copysignf(e, x);
}

typedef unsigned u32x2_t __attribute__((ext_vector_type(2)));
DI int swap32_sum(int a, int b) {
  const u32x2_t r = __builtin_amdgcn_permlane32_swap((unsigned)a, (unsigned)b, false, false);
  return (int)(r[0] + r[1]);
}
DI int swap16_sum(int a, int b) {
  const u32x2_t r = __builtin_amdgcn_permlane16_swap((unsigned)a, (unsigned)b, false, false);
  return (int)(r[0] + r[1]);
}
template <int CTRL> DI int dpp_mov(int x) { return __builtin_amdgcn_update_dpp(x, x, CTRL, 0xF, 0xF, false); }
DI float swap32_max(float x) {
  const u32x2_t r = __builtin_amdgcn_permlane32_swap(__float_as_uint(x), __float_as_uint(x), false, false);
  return fmaxf(__uint_as_float(r[0]), __uint_as_float(r[1]));
}
DI float gelu_f(float v) { return 0.5f * v * (1.f + fast_erf(v * 0.70710678118654752f)); }
DI float sigmoid_f(float z) { return __builtin_amdgcn_rcpf(1.f + __builtin_amdgcn_exp2f(-1.4426950408889634f * z)); }
DI void rope_sincos(float ang, float& s, float& c) {
  double rev = (double)ang * 0.15915494309189535;
  rev -= rint(rev);
  float fr = (float)rev;
  s = __builtin_amdgcn_sinf(fr);
  c = __builtin_amdgcn_cosf(fr);
}

#define GS 72
DI void gemm_tile(const bf16_t* __restrict__ A, int lda, const bf16_t* __restrict__ B, int ldb, int K,
                  bf16_t* sm, f32x16 (&acc)[2][2]) {
  const int tid = TIDX(), lane = tid & 63, wave = tid >> 6;
  const int r = lane & 31, h = lane >> 5, wm = wave >> 1, wn = wave & 1;
  const int lrow = tid >> 3, lch = tid & 7;
  u32x4 ra0_0, ra0_1, ra0_2, ra0_3, rb0_0, rb0_1, rb0_2, rb0_3, ra1_0, ra1_1, ra1_2, ra1_3, rb1_0, rb1_1, rb1_2, rb1_3;
  const bf16_t* ag = A + (size_t)lrow * lda + lch * 8;
  const bf16_t* bg = B + (size_t)lrow * ldb + lch * 8;
  const int nk = K >> 6;
#define GLOAD1(RA, RB, KO, I)                                               \
    RA##_##I = *(const u32x4*)(ag + (size_t)(I) * 32 * lda + (KO));         \
    RB##_##I = *(const u32x4*)(bg + (size_t)(I) * 32 * ldb + (KO));
#define GLOAD(RA, RB, KO) { GLOAD1(RA, RB, KO, 0) GLOAD1(RA, RB, KO, 1) GLOAD1(RA, RB, KO, 2) GLOAD1(RA, RB, KO, 3) }
#define SSTORE1(RA, RB, BUF, I)                                             \
    *(u32x4*)(sa + (BUF) * 128 * GS + soff + (I) * 32 * GS) = RA##_##I;     \
    *(u32x4*)(sb + (BUF) * 128 * GS + soff + (I) * 32 * GS) = RB##_##I;
#define SSTORE(RA, RB, BUF) { SSTORE1(RA, RB, BUF, 0) SSTORE1(RA, RB, BUF, 1) SSTORE1(RA, RB, BUF, 2) SSTORE1(RA, RB, BUF, 3) }
#define COMPUTE(BUF)                                                        \
  {                                                                         \
    const bf16_t* ca = sa + (BUF) * 128 * GS + (wm * 64 + r) * GS + h * 8;  \
    const bf16_t* cb = sb + (BUF) * 128 * GS + (wn * 64 + r) * GS + h * 8;  \
    bf16x8 fa0[4], fa1[4], fb0[4], fb1[4];                                  \
    fa0[0] = *(const bf16x8*)(ca); fa1[0] = *(const bf16x8*)(ca + 32 * GS); \
    fb0[0] = *(const bf16x8*)(cb); fb1[0] = *(const bf16x8*)(cb + 32 * GS); \
    __builtin_amdgcn_sched_barrier(0);                                      \
    _Pragma("unroll") for (int ks = 0; ks < 4; ++ks) {                      \
      if (ks < 3) {                                                         \
        fa0[ks + 1] = *(const bf16x8*)(ca + (ks + 1) * 16); fa1[ks + 1] = *(const bf16x8*)(ca + 32 * GS + (ks + 1) * 16); \
        fb0[ks + 1] = *(const bf16x8*)(cb + (ks + 1) * 16); fb1[ks + 1] = *(const bf16x8*)(cb + 32 * GS + (ks + 1) * 16); \
      }                                                                     \
      c00 = MFMA(fa0[ks], fb0[ks], c00);                                    \
      c01 = MFMA(fa0[ks], fb1[ks], c01);                                    \
      c10 = MFMA(fa1[ks], fb0[ks], c10);                                    \
      c11 = MFMA(fa1[ks], fb1[ks], c11);                                    \
      __builtin_amdgcn_sched_barrier(0);                                    \
    }                                                                       \
  }
  bf16_t* sa = sm;
  bf16_t* sb = sm + 2 * 128 * GS;
  const int soff = lrow * GS + lch * 8;
  GLOAD(ra0, rb0, 0)
  GLOAD(ra1, rb1, 64)
  f32x16 c00, c01, c10, c11;
  {
    const f32x16 z = {0.f, 0.f, 0.f, 0.f, 0.f, 0.f, 0.f, 0.f, 0.f, 0.f, 0.f, 0.f, 0.f, 0.f, 0.f, 0.f};
    c00 = z; c01 = z; c10 = z; c11 = z;
  }
  SSTORE(ra0, rb0, 0)
  if (nk > 2) { GLOAD(ra0, rb0, 128) }
  __syncthreads();
  for (int kt = 0; kt < nk; kt += 2) {
    COMPUTE(0)
    SSTORE(ra1, rb1, 1)
    if (kt + 3 < nk) { GLOAD(ra1, rb1, (kt + 3) * 64) }
    __syncthreads();
    COMPUTE(1)
    if (kt + 2 < nk) {
      SSTORE(ra0, rb0, 0)
      if (kt + 4 < nk) { GLOAD(ra0, rb0, (kt + 4) * 64) }
    }
    __syncthreads();
  }
  acc[0][0] = c00; acc[0][1] = c01; acc[1][0] = c10; acc[1][1] = c11;
#undef GLOAD
#undef GLOAD1
#undef SSTORE1
#undef SSTORE
#undef COMPUTE
}

DI void lds_mma_128(const bf16_t* sa, const bf16_t* sb, f32x16 (&acc)[2][2]) {
  const int tid = TIDX(), lane = tid & 63, wave = tid >> 6;
  const int r = lane & 31, h = lane >> 5, wm = wave >> 1, wn = wave & 1;
  const bf16_t* ca = sa + (wm * 64 + r) * GS + h * 8;
  const bf16_t* cb = sb + (wn * 64 + r) * GS + h * 8;
#pragma unroll
  for (int ks = 0; ks < 4; ++ks) {
    const bf16x8 a0 = *(const bf16x8*)(ca + ks * 16), a1 = *(const bf16x8*)(ca + 32 * GS + ks * 16);
    const bf16x8 b0 = *(const bf16x8*)(cb + ks * 16), b1 = *(const bf16x8*)(cb + 32 * GS + ks * 16);
    acc[0][0] = MFMA(a0, b0, acc[0][0]);
    acc[0][1] = MFMA(a0, b1, acc[0][1]);
    acc[1][0] = MFMA(a1, b0, acc[1][0]);
    acc[1][1] = MFMA(a1, b1, acc[1][1]);
  }
}
#define EPI_BEGIN                                                              \
  {                                                                            \
    const int _lane = TIDX() & 63, _wave = TIDX() >> 6;              \
    const int _r = _lane & 31, _h = _lane >> 5, _wm = _wave >> 1, _wn = _wave & 1; \
    _Pragma("unroll") for (int _i = 0; _i < 2; ++_i)                           \
    _Pragma("unroll") for (int _j = 0; _j < 2; ++_j)                           \
    _Pragma("unroll") for (int _q = 0; _q < 16; ++_q) {                        \
      const int trow = _wm * 64 + _i * 32 + (_q & 3) + 8 * (_q >> 2) + 4 * _h; \
      const int tcol = _wn * 64 + _j * 32 + _r;                                \
      const float val = acc[_i][_j][_q];
#define EPI_END }}


DI bool xcd_item(int it, int NT, int& mt, int& nt) {
  const int G = gridDim.x;
  if ((G & 7) != 0) { if (it >= 128 * NT) return false; mt = it / NT; nt = it - mt * NT; return true; }
  const int S = G >> 3;
  const int rnd = it / G, b = it - rnd * G;
  const int xcd = b & 7, slot = b >> 3;
  const int li = rnd * S + slot;
  if (li >= 16 * NT) return false;
  const int ml = li / NT;
  mt = 16 * xcd + ml; nt = li - ml * NT;
  return true;
}

struct WS {
  half_t* X; bf16_t* H; char* scr; bf16_t* QP; int* PIDX; float* PG; float* MODS; float* KVMODS; float* SUMA; float* SUMH;
  bf16_t* W; unsigned char* TU; unsigned char* TV; float* SU; float* SV;
};
DI WS make_ws(char* ws) {
  WS w;
  w.X = (half_t*)(ws + OFF_X); w.H = (bf16_t*)(ws + OFF_H); w.scr = ws + OFF_SCR; w.QP = (bf16_t*)(ws + OFF_QP);
  w.PIDX = (int*)(ws + OFF_PIDX); w.PG = (float*)(ws + OFF_PG); w.MODS = (float*)(ws + OFF_MODS);
  w.KVMODS = w.MODS + 4 * 2 * 6144; w.SUMA = (float*)(ws + OFF_SUM); w.SUMH = w.SUMA + 2 * 128 * 1024;
  w.W = (bf16_t*)(ws + OFF_W); w.TU = (unsigned char*)(ws + OFF_TU); w.TV = (unsigned char*)(ws + OFF_TV); w.SU = (float*)(ws + OFF_SU); w.SV = (float*)(ws + OFF_SV);
  return w;
}

DI void convert_table_item(const Params& p, const WS& w, int gid) {
  const int lane = TIDX() & 63, wave = TIDX() >> 6;
  const int which = (gid >> 10) & 1;
  const int row0 = ((gid >> 11) * 1024 + (gid & 1023)) * 16 + wave * 4;
  const float* src = which ? p.peer_v : p.peer_u;
  unsigned char* dst = which ? w.TV : w.TU;
  float* sc = which ? w.SV : w.SU;
  float4 v[4][4];
#pragma unroll
  for (int u = 0; u < 4; ++u)
#pragma unroll
    for (int i = 0; i < 4; ++i) {
      const f32x4_t t4 = __builtin_nontemporal_load((const f32x4_t*)(src + (size_t)(row0 + u) * 1024 + i * 256 + lane * 4));
      v[u][i] = make_float4(t4.x, t4.y, t4.z, t4.w);
    }
#pragma unroll
  for (int u = 0; u < 4; ++u) {
    const int row = row0 + u;
    float am = 0.f;
#pragma unroll
    for (int i = 0; i < 4; ++i)
      am = fmaxf(am, fmaxf(fmaxf(fabsf(v[u][i].x), fabsf(v[u][i].y)), fmaxf(fabsf(v[u][i].z), fabsf(v[u][i].w))));
#pragma unroll
    for (int o = 32; o > 0; o >>= 1) am = fmaxf(am, __shfl_xor(am, o));
    const float inv = am > 0.f ? 127.f / am : 0.f;
    const int bias = which ? 128 : 0;
#pragma unroll
    for (int i = 0; i < 4; ++i) {
      const int q0 = (int)rintf(v[u][i].x * inv) + bias, q1 = (int)rintf(v[u][i].y * inv) + bias;
      const int q2 = (int)rintf(v[u][i].z * inv) + bias, q3 = (int)rintf(v[u][i].w * inv) + bias;
      *(unsigned*)(dst + (size_t)row * 1024 + i * 256 + lane * 4) =
          (unsigned)(q0 & 255) | ((unsigned)(q1 & 255) << 8) | ((unsigned)(q2 & 255) << 16) | ((unsigned)(q3 & 255) << 24);
    }
    if (lane == 0) sc[row] = am * (1.f / 127.f);
  }
}

DI void phase_prep(const Params& p, const WS& w, char* smem) {
  const int tid = TIDX(), lane = tid & 63, wave = tid >> 6;
  TJob* sj = (TJob*)(smem + SMEM_MAIN);
  const int n_mods = 416, n_tconv = p.n_tconv, n_keys = 512, n_pad = 1, n_tab = 2048;
  const int total = n_mods + n_tconv + n_keys + n_pad + n_tab;
  for (int it0 = blockIdx.x; it0 < total; it0 += gridDim.x) {
    int it = it0;
    if (it < n_mods) {
      float* sc = (float*)smem;
      float* red = sc + 2048;
      for (int i = tid; i < 2048; i += 256) { float v = p.c[i]; sc[i] = v / (1.f + __expf(-v)); }
      __syncthreads();
      const int gcol = it * 64 + lane;
      const float* Wp; int ld, l = 0, j;
      if (gcol < 24576) { l = gcol / 6144; j = gcol - l * 6144; Wp = p.ada_w + (size_t)l * 1024 * 6144 + j; ld = 6144; }
      else { j = gcol - 24576; Wp = p.kv_ada_w + j; ld = 2048; l = 4; }
      float a0 = 0.f, a1 = 0.f;
      const int k0 = wave * 256;
#pragma unroll 1
      for (int kb = 0; kb < 256; kb += 32) {
        float wv[32];
#pragma unroll
        for (int k = 0; k < 32; ++k) wv[k] = __builtin_nontemporal_load(Wp + (size_t)(k0 + kb + k) * ld);
#pragma unroll
        for (int k = 0; k < 32; ++k) { a0 += sc[k0 + kb + k] * wv[k]; a1 += sc[1024 + k0 + kb + k] * wv[k]; }
      }
      red[(wave * 64 + lane) * 2] = a0; red[(wave * 64 + lane) * 2 + 1] = a1;
      __syncthreads();
      if (wave == 0) {
        float s0 = 0.f, s1 = 0.f;
#pragma unroll
        for (int q = 0; q < 4; ++q) { s0 += red[(q * 64 + lane) * 2]; s1 += red[(q * 64 + lane) * 2 + 1]; }
        if (l < 4) {
          float bb = p.ada_b[l * 6144 + j];
          w.MODS[(l * 2 + 0) * 6144 + j] = s0 + bb; w.MODS[(l * 2 + 1) * 6144 + j] = s1 + bb;
        } else {
          float bb = p.kv_ada_b[j];
          w.KVMODS[j] = s0 + bb; w.KVMODS[2048 + j] = s1 + bb;
        }
      }
      __syncthreads();
      continue;
    }
    it -= n_mods;
    if (it < n_tconv) {
      int jj = 0;
      for (int q = 0; q < NJOBS; ++q) if (it >= sj[q].tile0) jj = q;
      const TJob jb = sj[jj];
      float* tile = (float*)smem;
      const int tiles_n = (jb.N + 63) >> 6;
      const int lt = it - jb.tile0;
      const int tk = lt / tiles_n, tn = lt - tk * tiles_n;
      const int k0 = tk * 64, n0 = tn * 64;
      {
        const int nl = tid & 63, kl0 = tid >> 6;
        float tv[16];
#pragma unroll
        for (int i = 0; i < 16; ++i) {
          const int kl = kl0 + 4 * i;
          tv[i] = (n0 + nl < jb.N) ? jb.src[(size_t)(k0 + kl) * jb.N + n0 + nl] : 0.f;
        }
#pragma unroll
        for (int i = 0; i < 16; ++i) tile[(kl0 + 4 * i) * 65 + nl] = tv[i];
      }
      __syncthreads();
      {
        const int nl = tid >> 2, kq = tid & 3;
        if (n0 + nl < jb.N) {
          const int n = jb.rowbase + n0 + nl;
          const int drow = (jb.mode == 0) ? n : (64 * (n >> 5) + 32 * (jb.mode - 1) + (n & 31));
          unsigned pk[8];
#pragma unroll
          for (int e = 0; e < 8; ++e) pk[e] = pack2(tile[(kq * 16 + 2 * e) * 65 + nl], tile[(kq * 16 + 2 * e + 1) * 65 + nl]);
          uint4* dp = (uint4*)(jb.dst + (size_t)drow * jb.ldd + k0 + kq * 16);
          dp[0] = make_uint4(pk[0], pk[1], pk[2], pk[3]);
          dp[1] = make_uint4(pk[4], pk[5], pk[6], pk[7]);
        }
      }
      __syncthreads();
      continue;
    }
    it -= n_tconv;
    if (it < n_keys) {
      const size_t e = (size_t)it * 2048 + tid * 8;
      const float4 v0 = *(const float4*)(p.peer_keys + e), v1 = *(const float4*)(p.peer_keys + e + 4);
      *(uint4*)(w.W + W_KEYS + e) = make_uint4(pack2(v0.x, v0.y), pack2(v0.z, v0.w), pack2(v1.x, v1.y), pack2(v1.z, v1.w));
      continue;
    }
    it -= n_keys;
    if (it < n_pad) {
      uint4* dp = (uint4*)(w.W + W_DKV + 288 * 1024);
      for (int i = tid; i < 96 * 1024 / 8; i += 256) dp[i] = make_uint4(0, 0, 0, 0);
      continue;
    }
    it -= n_pad;
    convert_table_item(p, w, it);
  }
}

template <bool HALF_IN>
DI void phase_norm_rows(const void* __restrict__ Xv, const float* __restrict__ g, const float* __restrict__ shift0,
                        const float* __restrict__ scale0, int bstride, bf16_t* __restrict__ out) {
  const int lane = TIDX() & 63, wave = TIDX() >> 6;
  for (int it = blockIdx.x; it < T / 4; it += gridDim.x) {
    const int t = it * 4 + wave, b = t >> 13;
    float4 v[4]; float ss = 0.f;
#pragma unroll
    for (int i = 0; i < 4; ++i) {
      if (HALF_IN) {
        const uint2 hv = *(const uint2*)((const half_t*)Xv + (size_t)t * D + i * 256 + lane * 4);
        v[i] = make_float4(hlo(hv.x), hhi(hv.x), hlo(hv.y), hhi(hv.y));
      } else {
        v[i] = *(const float4*)((const float*)Xv + (size_t)t * D + i * 256 + lane * 4);
      }
      ss += v[i].x * v[i].x + v[i].y * v[i].y + v[i].z * v[i].z + v[i].w * v[i].w;
    }
    ss = wave_sum(ss);
    const float rinv = rsqrtf(ss * (1.f / 1024.f) + 1e-6f);
#pragma unroll
    for (int i = 0; i < 4; ++i) {
      const int col = i * 256 + lane * 4;
      const float4 gg = *(const float4*)(g + col);
      const float4 sc = *(const float4*)(scale0 + b * bstride + col);
      const float4 sh = *(const float4*)(shift0 + b * bstride + col);
      const float y0 = v[i].x * rinv * gg.x * (1.f + sc.x) + sh.x, y1 = v[i].y * rinv * gg.y * (1.f + sc.y) + sh.y;
      const float y2 = v[i].z * rinv * gg.z * (1.f + sc.z) + sh.z, y3 = v[i].w * rinv * gg.w * (1.f + sc.w) + sh.w;
      *(uint2*)(out + (size_t)t * D + col) = make_uint2(pack2(y0, y1), pack2(y2, y3));
    }
  }
}

DI void phase_win(const Params& p, const WS& w, int l, char* smem) {
  int bg = 2048 + blockIdx.x;
  bf16_t* G = (bf16_t*)(w.scr + SA_G); bf16_t* REC = (bf16_t*)(w.scr + SA_REC);
  const bf16_t* Wt = w.W + W_WIN + (size_t)l * 2048 * 1024;
  for (int it = blockIdx.x; it < 128 * 16 + (int)gridDim.x; it += gridDim.x) {
    int mt, nt;
    if (!xcd_item(it, 16, mt, nt)) break;
    const int m0 = mt * 128, n0 = nt * 128;
    f32x16 acc[2][2];
    gemm_tile(w.H + (size_t)m0 * D, D, Wt + (size_t)n0 * D, D, D, (bf16_t*)smem, acc);
    if (n0 < 1024) {
      EPI_BEGIN G[(size_t)(m0 + trow) * D + n0 + tcol] = f2bf(gelu_f(val)); EPI_END
    } else {
      EPI_BEGIN REC[(size_t)(m0 + trow) * D + (n0 - 1024) + tcol] = f2bf(val); EPI_END
    }
    if (l == 0 && bg < 3584) { convert_table_item(p, w, bg); bg += gridDim.x; }
  }
  if (l == 0) for (; bg < 3584; bg += gridDim.x) convert_table_item(p, w, bg);
}
DI void phase_conv(const Params& p, const WS& w, int l) {
  const bf16_t* REC = (const bf16_t*)(w.scr + SA_REC); bf16_t* XC = (bf16_t*)(w.scr + SA_XC);
  const float* cw = p.lru_conv_w + l * 4 * 1024; const float* cb = p.lru_conv_b + l * 1024;
  for (int it = blockIdx.x; it < T * 128 / 256; it += gridDim.x) {
    const int gi = it * 256 + TIDX();
    const int t = gi >> 7, c0 = (gi & 127) * 8, s = t & (SEQ - 1);
    float a[8];
    {
      const float4 b0 = *(const float4*)(cb + c0), b1 = *(const float4*)(cb + c0 + 4);
      a[0] = b0.x; a[1] = b0.y; a[2] = b0.z; a[3] = b0.w; a[4] = b1.x; a[5] = b1.y; a[6] = b1.z; a[7] = b1.w;
    }
#pragma unroll
    for (int k = 0; k < 4; ++k) {
      const int ds = 3 - k;
      if (s - ds >= 0) {
        const uint4 rv = *(const uint4*)(REC + (size_t)(t - ds) * D + c0);
        const float4 w0 = *(const float4*)(cw + k * 1024 + c0), w1 = *(const float4*)(cw + k * 1024 + c0 + 4);
        a[0] += bflo(rv.x) * w0.x; a[1] += bfhi(rv.x) * w0.y; a[2] += bflo(rv.y) * w0.z; a[3] += bfhi(rv.y) * w0.w;
        a[4] += bflo(rv.z) * w1.x; a[5] += bfhi(rv.z) * w1.y; a[6] += bflo(rv.w) * w1.z; a[7] += bfhi(rv.w) * w1.w;
      }
    }
    *(uint4*)(XC + (size_t)t * D + c0) = make_uint4(pack2(a[0], a[1]), pack2(a[2], a[3]), pack2(a[4], a[5]), pack2(a[6], a[7]));
  }
}
DI void phase_gates(const Params& p, const WS& w, int l, char* smem) {
  int bg = 3584 + blockIdx.x;
  const bf16_t* XC = (const bf16_t*)(w.scr + SA_XC);
  bf16_t* AA = (bf16_t*)(w.scr + SA_AA); bf16_t* BB = (bf16_t*)(w.scr + SA_BB);
  const bf16_t* Wt = w.W + W_GATE + (size_t)l * 2048 * 256;
  const float* ba = p.lru_ba + l * 1024; const float* bx = p.lru_bx + l * 1024; const float* lam = p.lru_lambda + l * 1024;
  const int lane = TIDX() & 63, wave = TIDX() >> 6, r = lane & 31, h = lane >> 5, wm = wave >> 1, wn = wave & 1;
  for (int it = blockIdx.x; it < 128 * 16 + (int)gridDim.x; it += gridDim.x) {
    int mt, nt;
    if (!xcd_item(it, 16, mt, nt)) break;
    const int m0 = mt * 128, n0 = nt * 128;
    const int head = n0 >> 9;
    f32x16 acc[2][2];
    gemm_tile(XC + (size_t)m0 * D + head * 256, D, Wt + (size_t)n0 * 256, 256, 256, (bf16_t*)smem, acc);
    const int c = 32 * ((n0 >> 6) + wn) + r;
    const float bac = ba[c], bxc = bx[c];
    const float sp = log1pf(__expf(-lam[c]));
#pragma unroll
    for (int i = 0; i < 2; ++i)
#pragma unroll
      for (int q = 0; q < 16; ++q) {
        const int row = m0 + wm * 64 + i * 32 + (q & 3) + 8 * (q >> 2) + 4 * h;
        const float rg = sigmoid_f(acc[i][0][q] + bac), ig = sigmoid_f(acc[i][1][q] + bxc);
        const float la = -8.f * rg * sp;
        const float av = __builtin_amdgcn_exp2f(1.4426950408889634f * la);
        const float xc = bf2f(XC[(size_t)row * D + c]);
        const float bv = __builtin_amdgcn_sqrtf(fmaxf(1.f - av * av, 0.f)) * (ig * xc);
        const bf16_t omh = f2bf(1.f - av), bvh = f2bf(bv);
        AA[(size_t)row * D + c] = omh; BB[(size_t)row * D + c] = bvh;
        acc[i][0][q] = 1.f - bf2f(omh); acc[i][1][q] = bf2f(bvh);
      }
    {
      float sa[8], sh[8];
#pragma unroll
      for (int i = 0; i < 2; ++i)
#pragma unroll
        for (int g = 0; g < 4; ++g) {
          float hh = 0.f, ap = 1.f;
#pragma unroll
          for (int e = 0; e < 4; ++e) { const float a = acc[i][0][g * 4 + e], bb = acc[i][1][g * 4 + e]; hh = a * hh + bb; ap *= a; }
          sa[i * 4 + g] = ap; sh[i * 4 + g] = hh;
        }
      float HH = 0.f, AP = 1.f;
#pragma unroll
      for (int sgi = 0; sgi < 8; ++sgi) {
        const float pa = __shfl_xor(sa[sgi], 32), ph = __shfl_xor(sh[sgi], 32);
        HH = sa[sgi] * HH + sh[sgi]; AP *= sa[sgi];
        HH = pa * HH + ph; AP *= pa;
      }
      if (h == 0) {
        const int t0 = m0 + wm * 64;
        const int bb2 = t0 >> 13, chn = (t0 & (SEQ - 1)) >> 6;
        w.SUMA[(bb2 * 128 + chn) * 1024 + c] = AP; w.SUMH[(bb2 * 128 + chn) * 1024 + c] = HH;
      }
    }
    if (l == 0 && bg < 5120) { convert_table_item(p, w, bg); bg += gridDim.x; }
  }
  if (l == 0) for (; bg < 5120; bg += gridDim.x) convert_table_item(p, w, bg);
}
DI void phase_scan1(const WS& w) {
  const float* AA = (const float*)(w.scr + SA_AA); const float* BB = (const float*)(w.scr + SA_BB);
  for (int it = blockIdx.x; it < 1024; it += gridDim.x) {
    const int cg4 = it & 3, ch = (it >> 2) & 127, b = it >> 9;
    const int col = cg4 * 256 + TIDX();
    const size_t base = ((size_t)b * SEQ + ch * 64) * D + col;
    float hh = 0.f, ap = 1.f;
#pragma unroll 8
    for (int s = 0; s < 64; ++s) {
      const float a = AA[base + (size_t)s * D], bv = BB[base + (size_t)s * D];
      hh = a * hh + bv; ap *= a;
    }
    w.SUMA[(b * 128 + ch) * 1024 + col] = ap; w.SUMH[(b * 128 + ch) * 1024 + col] = hh;
  }
}
DI void phase_scan2(const WS& w) {
  const bf16_t* AA = (const bf16_t*)(w.scr + SA_AA); const bf16_t* BB = (const bf16_t*)(w.scr + SA_BB);
  const bf16_t* G = (const bf16_t*)(w.scr + SA_G); bf16_t* YG = (bf16_t*)(w.scr + SA_YG);
  for (int it = blockIdx.x; it < 1024; it += gridDim.x) {
    const int cg4 = it & 3, ch0 = (it >> 2) & 127, b = it >> 9;
    const int ch = b ? (127 - ch0) : ch0;
    const int col = cg4 * 256 + TIDX();
    float hh = 0.f;
    {
      const float* pa = w.SUMA + (size_t)b * 128 * 1024 + col; const float* ph = w.SUMH + (size_t)b * 128 * 1024 + col;
      int c2 = 0;
#pragma unroll 1
      for (; c2 + 16 <= ch; c2 += 16) {
        float sa[16], sh[16];
#pragma unroll
        for (int k = 0; k < 16; ++k) { sa[k] = pa[(c2 + k) * 1024]; sh[k] = ph[(c2 + k) * 1024]; }
#pragma unroll
        for (int k = 0; k < 16; ++k) hh = sa[k] * hh + sh[k];
      }
#pragma unroll 1
      for (; c2 < ch; ++c2) hh = pa[c2 * 1024] * hh + ph[c2 * 1024];
    }
    const size_t base = ((size_t)b * SEQ + ch * 64) * D + col;
#pragma unroll 1
    for (int s0 = 0; s0 < 64; s0 += 16) {
      bf16_t ra[16], rb[16], rg[16];
#pragma unroll
      for (int k = 0; k < 16; ++k) { ra[k] = AA[base + (size_t)(s0 + k) * D]; rb[k] = BB[base + (size_t)(s0 + k) * D]; rg[k] = G[base + (size_t)(s0 + k) * D]; }
#pragma unroll
      for (int k = 0; k < 16; ++k) {
        hh = (1.f - bf2f(ra[k])) * hh + bf2f(rb[k]);
        YG[base + (size_t)(s0 + k) * D] = f2bf(bf2f(rg[k]) * hh);
      }
    }
  }
}
DI void phase_outproj(const Params& p, const WS& w, int l, char* smem, bool dry) {
  int bg = 5120 + blockIdx.x;
  const bf16_t* A = (l < 2) ? (const bf16_t*)(w.scr + SA_YG) : (const bf16_t*)(w.scr + SB_AO);
  const bf16_t* Wt = (l < 2) ? (w.W + W_WOUT + (size_t)l * 1024 * 1024) : (w.W + W_WO + (size_t)(l - 2) * 1024 * 1024);
  for (int it = blockIdx.x; it < 128 * 8 + (int)gridDim.x; it += gridDim.x) {
    int mt, nt;
    if (!xcd_item(it, 8, mt, nt)) break;
    const int m0 = mt * 128, n0 = nt * 128;
    const float* g1 = w.MODS + (l * 2 + (m0 >> 13)) * 6144 + 2048;
    f32x16 acc[2][2];
    gemm_tile(A + (size_t)m0 * D, D, Wt + (size_t)n0 * D, D, D, (bf16_t*)smem, acc);
    EPI_BEGIN
      const size_t o = (size_t)(m0 + trow) * D + n0 + tcol;
      if (!dry) { const float xi = (l == 0) ? p.x[o] : (float)w.X[o]; w.X[o] = (half_t)(xi + g1[n0 + tcol] * val); }
    EPI_END
    if (l == 0 && !dry && bg < 6656) { convert_table_item(p, w, bg); bg += gridDim.x; }
  }
  if (l == 0 && !dry) for (; bg < 6656; bg += gridDim.x) convert_table_item(p, w, bg);
}
DI void phase_peerq(const WS& w, int l, char* smem) {
  const bf16_t* Wt = w.W + W_PQ + (size_t)l * 2048 * 1024;
  for (int it = blockIdx.x; it < 128 * 16; it += gridDim.x) {
    const int mt = it >> 4, nt = it & 15, m0 = mt * 128, n0 = nt * 128;
    f32x16 acc[2][2];
    gemm_tile(w.H + (size_t)m0 * D, D, Wt + (size_t)n0 * D, D, D, (bf16_t*)smem, acc);
    EPI_BEGIN w.QP[(size_t)(m0 + trow) * 2048 + n0 + tcol] = f2bf(val); EPI_END
  }
}
DI float key2f(int k) { unsigned b = (unsigned)(k ^ ((k >> 31) & 0x7fffffff)); return __uint_as_float(b & ~127u); }
DI int key2i(int k) { unsigned b = (unsigned)(k ^ ((k >> 31) & 0x7fffffff)); return (int)(b & 127u); }
DI void phase_topk(const Params& p, const WS& w, int l, char* smem) {
  int bg = 6656 + blockIdx.x;
  int* S = (int*)smem;
  const bf16_t* KB = w.W + W_KEYS + (size_t)l * 262144;
  const bf16_t* PQ = w.W + W_PQ + (size_t)l * 2048 * 1024;
  const int tid = TIDX();
  for (int it = blockIdx.x; it < 1024 + (int)gridDim.x; it += gridDim.x) {
    int mt, hd;
    if (!xcd_item(it, 8, mt, hd)) break;
    const int m0 = mt * 128;
    int L1[16];
#pragma unroll
    for (int q = 0; q < 16; ++q) L1[q] = 0;
#pragma unroll 1
    for (int pp = 0; pp < 2; ++pp) {
      {
        f32x16 acc[2][2];
        {
          f32x16 acc1[2][2];
          gemm_tile(w.H + (size_t)m0 * D, D, PQ + (size_t)(hd * 2 + pp) * 128 * D, D, D, (bf16_t*)smem, acc1);
          bf16_t* sa = (bf16_t*)smem; bf16_t* sb = sa + 2 * 128 * GS;
          {
            const int _lane = TIDX() & 63, _wave = TIDX() >> 6;
            const int _r = _lane & 31, _h = _lane >> 5, _wm = _wave >> 1, _wn = _wave & 1;
#pragma unroll
            for (int _i = 0; _i < 2; ++_i)
#pragma unroll
              for (int _j = 0; _j < 2; ++_j)
#pragma unroll
                for (int _q = 0; _q < 16; ++_q) {
                  const int trow = _wm * 64 + _i * 32 + (_q & 3) + 8 * (_q >> 2) + 4 * _h;
                  sa[_wn * 128 * GS + trow * GS + _j * 32 + _r] = f2bf(acc1[_i][_j][_q]);
                }
          }
          {
            const bf16_t* kg = KB + (size_t)(hd * 2 + pp) * 16384;
            const int krow = tid >> 3, kch = tid & 7;
#pragma unroll
            for (int i2 = 0; i2 < 4; ++i2) {
              const u32x4 k0 = *(const u32x4*)(kg + (krow + 32 * i2) * 128 + kch * 8);
              const u32x4 k1 = *(const u32x4*)(kg + (krow + 32 * i2) * 128 + 64 + kch * 8);
              *(u32x4*)(sb + (krow + 32 * i2) * GS + kch * 8) = k0;
              *(u32x4*)(sb + 128 * GS + (krow + 32 * i2) * GS + kch * 8) = k1;
            }
          }
          __syncthreads();
          {
            const f32x16 z = {0.f, 0.f, 0.f, 0.f, 0.f, 0.f, 0.f, 0.f, 0.f, 0.f, 0.f, 0.f, 0.f, 0.f, 0.f, 0.f};
            acc[0][0] = z; acc[0][1] = z; acc[1][0] = z; acc[1][1] = z;
          }
          lds_mma_128(sa, sb, acc);
          lds_mma_128(sa + 128 * GS, sb + 128 * GS, acc);
          __syncthreads();
        }
        EPI_BEGIN
          const unsigned bits = (__float_as_uint(val) & ~127u) | (unsigned)tcol;
          const int key = (int)bits ^ (((int)bits >> 31) & 0x7fffffff);
          S[trow * 128 + (tcol ^ (trow & 31))] = key;
        EPI_END
      }
      __syncthreads();
      const int row = tid & 127, half = tid >> 7;
      int top[16];
      {
        int e[64];
#pragma unroll
        for (int c = 0; c < 64; ++c) e[c] = S[row * 128 + half * 64 + (c ^ (row & 31))];
#pragma unroll
        for (int gb = 0; gb < 64; gb += 16) {
#pragma unroll
          for (int k = 2; k <= 16; k <<= 1) {
#pragma unroll
            for (int j = k >> 1; j > 0; j >>= 1) {
#pragma unroll
              for (int i = 0; i < 16; ++i) {
                const int l2 = i ^ j;
                if (l2 > i) {
                  const bool desc = ((i & k) == 0);
                  const int a = e[gb + i], b = e[gb + l2];
                  const int hi = max(a, b), lo = min(a, b);
                  e[gb + i] = desc ? hi : lo; e[gb + l2] = desc ? lo : hi;
                }
              }
            }
          }
        }
#pragma unroll
        for (int step = 0; step < 3; ++step) {
          const int ga = (step == 1) ? 32 : 0, gbb = (step == 0) ? 16 : ((step == 1) ? 48 : 32);
#pragma unroll
          for (int i = 0; i < 16; ++i) e[ga + i] = max(e[ga + i], e[gbb + 15 - i]);
#pragma unroll
          for (int j = 8; j > 0; j >>= 1) {
#pragma unroll
            for (int i = 0; i < 16; ++i) {
              const int l2 = i ^ j;
              if (l2 > i) {
                const int a = e[ga + i], b = e[ga + l2];
                e[ga + i] = max(a, b); e[ga + l2] = min(a, b);
              }
            }
          }
        }
#pragma unroll
        for (int tt = 0; tt < 16; ++tt) top[tt] = e[tt];
      }
      __syncthreads();
#pragma unroll
      for (int tt = 0; tt < 16; ++tt) S[(row * 2 + half) * 16 + tt] = top[tt];
      __syncthreads();
      if (tid < 128) {
        int m[16]; int pa = 0, pb = 0;
#pragma unroll
        for (int tt = 0; tt < 16; ++tt) {
          const int a = S[(tid * 2) * 16 + pa], b = S[(tid * 2 + 1) * 16 + pb];
          if (a > b) { m[tt] = a; ++pa; } else { m[tt] = b; ++pb; }
        }
        if (pp == 0) {
#pragma unroll
          for (int q = 0; q < 16; ++q) L1[q] = m[q];
        } else {
          int* S2 = S + 4096 + tid * 16;
#pragma unroll
          for (int q = 0; q < 16; ++q) S2[q] = m[q];
          unsigned long long P = 0ull;
          float cv[16]; int ce[16];
#pragma unroll
          for (int tt = 0; tt < 16; ++tt) {
            float best = -3.0e38f; int besta = 0, beste = 0;
#pragma unroll
            for (int a = 0; a <= tt; ++a) {
              const int pa2 = (int)((P >> (4 * a)) & 15ull);
              const int k2 = S2[pa2];
              const float cand = key2f(L1[a]) + key2f(k2);
              if (cand > best) { best = cand; besta = a; beste = key2i(L1[a]) * 128 + key2i(k2); }
            }
            cv[tt] = best; ce[tt] = beste;
            P += 1ull << (4 * besta);
          }
          float sum = 0.f;
          const float cmax = cv[0];
#pragma unroll
          for (int q = 0; q < 16; ++q) { cv[q] = __expf(cv[q] - cmax); sum += cv[q]; }
          const float inv = 1.f / sum;
          int* ip = w.PIDX + ((size_t)(m0 + tid) * 8 + hd) * 16;
          float* gp = w.PG + ((size_t)(m0 + tid) * 8 + hd) * 16;
#pragma unroll
          for (int q = 0; q < 4; ++q) {
            *(int4*)(ip + q * 4) = make_int4(ce[q * 4], ce[q * 4 + 1], ce[q * 4 + 2], ce[q * 4 + 3]);
            *(float4*)(gp + q * 4) = make_float4(cv[q * 4] * inv, cv[q * 4 + 1] * inv, cv[q * 4 + 2] * inv, cv[q * 4 + 3] * inv);
          }
        }
      }
      __syncthreads();
    }
    if (l == 0 && bg < 8192) { convert_table_item(p, w, bg); bg += gridDim.x; }
  }
  if (l == 0) for (; bg < 8192; bg += gridDim.x) convert_table_item(p, w, bg);
}
DI void phase_exp(const Params& p, const WS& w, int l, bool dry) {
  const unsigned char* TU = w.TU + (size_t)l * 16384 * 1024; const unsigned char* TV = w.TV + (size_t)l * 16384 * 1024;
  const float* SU = w.SU + l * 16384; const float* SV = w.SV + l * 16384;
  const int lane = TIDX() & 63, wave = TIDX() >> 6;
  const bool hi5 = (lane & 32) != 0, hi4 = (lane & 16) != 0, hi3 = (lane & 8) != 0;
  const int esel = (lane >> 3) & 7;
  for (int it = blockIdx.x; it < T / 4; it += gridDim.x) {
    const int t = __builtin_amdgcn_readfirstlane(it * 4 + wave);
    const int b = t >> 13;
    int hq[4]; float hs;
    {
      const u32x4* hp = (const u32x4*)(w.H + (size_t)t * D + lane * 16);
      const u32x4 ha = hp[0], hb = hp[1];
      float hv[16];
      hv[0] = bflo(ha.x); hv[1] = bfhi(ha.x); hv[2] = bflo(ha.y); hv[3] = bfhi(ha.y); hv[4] = bflo(ha.z); hv[5] = bfhi(ha.z); hv[6] = bflo(ha.w); hv[7] = bfhi(ha.w);
      hv[8] = bflo(hb.x); hv[9] = bfhi(hb.x); hv[10] = bflo(hb.y); hv[11] = bfhi(hb.y); hv[12] = bflo(hb.z); hv[13] = bfhi(hb.z); hv[14] = bflo(hb.w); hv[15] = bfhi(hb.w);
      float am = 0.f;
#pragma unroll
      for (int q = 0; q < 16; ++q) am = fmaxf(am, fabsf(hv[q]));
#pragma unroll
      for (int o = 32; o > 0; o >>= 1) am = fmaxf(am, __shfl_xor(am, o));
      const float inv = am > 0.f ? 127.f / am : 0.f;
      hs = am * (1.f / 127.f);
#pragma unroll
      for (int q = 0; q < 4; ++q) {
        const int q0 = (int)rintf(hv[q * 4] * inv), q1 = (int)rintf(hv[q * 4 + 1] * inv), q2 = (int)rintf(hv[q * 4 + 2] * inv), q3 = (int)rintf(hv[q * 4 + 3] * inv);
        hq[q] = (int)((unsigned)(q0 & 255) | ((unsigned)(q1 & 255) << 8) | ((unsigned)(q2 & 255) << 16) | ((unsigned)(q3 & 255) << 24));
      }
    }
    const int* ip = w.PIDX + (size_t)t * 128; const float* gp = w.PG + (size_t)t * 128;
    const int mi0 = ip[lane], mi1 = ip[64 + lane]; const float mg0 = gp[lane], mg1 = gp[64 + lane];
    float out[16];
#pragma unroll
    for (int q = 0; q < 16; ++q) out[q] = 0.f;
    float csum = 0.f;
#define EXP_LOAD(P, E0)                                                       \
    {                                                                         \
      const int _mi = ((E0) < 64) ? mi0 : mi1; const float _mg = ((E0) < 64) ? mg0 : mg1; \
      const int _eb = (E0) & 63;                                              \
      _Pragma("unroll") for (int q = 0; q < 8; ++q) {                         \
        const int _id = __builtin_amdgcn_readlane(_mi, _eb + q);              \
        uu##P[q] = *(const u32x4*)(TU + (size_t)_id * 1024 + lane * 16);      \
        vv##P[q] = *(const u32x4*)(TV + (size_t)_id * 1024 + lane * 16);      \
        sv##P[q] = SV[_id];                                                   \
      }                                                                       \
      const int _idsel = __shfl(_mi, _eb + esel);                             \
      gs##P = __shfl(_mg, _eb + esel);                                        \
      su##P = SU[_idsel];                                                     \
    }
#define EXP_COMPUTE(P)                                                        \
    {                                                                         \
      int d[8];                                                               \
      _Pragma("unroll") for (int q = 0; q < 8; ++q) {                         \
        int a0 = __builtin_amdgcn_sdot4((int)uu##P[q].x, hq[0], 0, false);    \
        int a1 = __builtin_amdgcn_sdot4((int)uu##P[q].y, hq[1], 0, false);    \
        a0 = __builtin_amdgcn_sdot4((int)uu##P[q].z, hq[2], a0, false);       \
        a1 = __builtin_amdgcn_sdot4((int)uu##P[q].w, hq[3], a1, false);       \
        d[q] = a0 + a1;                                                       \
      }                                                                       \
      int k4[4];                                                              \
      _Pragma("unroll") for (int q = 0; q < 4; ++q) k4[q] = swap32_sum(d[q], d[4 + q]); \
      int m2[2];                                                              \
      _Pragma("unroll") for (int q = 0; q < 2; ++q) m2[q] = swap16_sum(k4[q], k4[2 + q]); \
      int n1 = (hi3 ? m2[1] : m2[0]) + dpp_mov<0x140>(hi3 ? m2[0] : m2[1]);   \
      n1 += dpp_mov<0xB1>(n1); n1 += dpp_mov<0x4E>(n1); n1 += dpp_mov<0x141>(n1); \
      const float act = (float)n1 * (su##P * hs);                             \
      const float wv = gs##P * gelu_f(act);                                   \
      const int wvi = __builtin_bit_cast(int, wv);                            \
      _Pragma("unroll") for (int q = 0; q < 8; ++q) {                         \
        const float cq = __builtin_bit_cast(float, __builtin_amdgcn_readlane(wvi, 8 * q)) * sv##P[q]; \
        csum += cq;                                                           \
        const unsigned x0 = vv##P[q].x, x1 = vv##P[q].y, x2 = vv##P[q].z, x3 = vv##P[q].w; \
        out[0] += cq * (float)(x0 & 255u); out[1] += cq * (float)((x0 >> 8) & 255u); out[2] += cq * (float)((x0 >> 16) & 255u); out[3] += cq * (float)(x0 >> 24); \
        out[4] += cq * (float)(x1 & 255u); out[5] += cq * (float)((x1 >> 8) & 255u); out[6] += cq * (float)((x1 >> 16) & 255u); out[7] += cq * (float)(x1 >> 24); \
        out[8] += cq * (float)(x2 & 255u); out[9] += cq * (float)((x2 >> 8) & 255u); out[10] += cq * (float)((x2 >> 16) & 255u); out[11] += cq * (float)(x2 >> 24); \
        out[12] += cq * (float)(x3 & 255u); out[13] += cq * (float)((x3 >> 8) & 255u); out[14] += cq * (float)((x3 >> 16) & 255u); out[15] += cq * (float)(x3 >> 24); \
      }                                                                       \
    }
    u32x4 uuA[8], vvA[8], uuB[8], vvB[8]; float svA[8], svB[8]; float gsA, gsB, suA, suB;
    EXP_LOAD(A, 0)
#pragma unroll 1
    for (int e0 = 0; e0 < 128; e0 += 16) {
      EXP_LOAD(B, e0 + 8)
      EXP_COMPUTE(A)
      { const int en = (e0 + 16 < 128) ? (e0 + 16) : 120; EXP_LOAD(A, en) }
      EXP_COMPUTE(B)
    }
#undef EXP_LOAD
#undef EXP_COMPUTE
    if (dry) continue;
    const float* g2 = w.MODS + (l * 2 + b) * 6144 + 5120;
    const int c0 = lane * 16;
    float xn[16]; float ss = 0.f;
#pragma unroll
    for (int i = 0; i < 4; ++i) {
      const uint2 xh = *(const uint2*)(w.X + (size_t)t * D + c0 + i * 4);
      const float4 x0 = make_float4(hlo(xh.x), hhi(xh.x), hlo(xh.y), hhi(xh.y));
      const float4 ga = *(const float4*)(g2 + c0 + i * 4);
      xn[i * 4 + 0] = x0.x + ga.x * (out[i * 4 + 0] - 128.f * csum); xn[i * 4 + 1] = x0.y + ga.y * (out[i * 4 + 1] - 128.f * csum);
      xn[i * 4 + 2] = x0.z + ga.z * (out[i * 4 + 2] - 128.f * csum); xn[i * 4 + 3] = x0.w + ga.w * (out[i * 4 + 3] - 128.f * csum);
    }
#pragma unroll
    for (int q = 0; q < 16; ++q) ss += xn[q] * xn[q];
    ss = wave_sum(ss);
    const float rinv = rsqrtf(ss * (1.f / 1024.f) + 1e-6f);
    if (l == 3) {
#pragma unroll
      for (int i = 0; i < 4; ++i) {
        const float4 ga = *(const float4*)(p.final_g + c0 + i * 4);
        *(float4*)(p.out + (size_t)t * D + c0 + i * 4) = make_float4(xn[i * 4] * rinv * ga.x, xn[i * 4 + 1] * rinv * ga.y, xn[i * 4 + 2] * rinv * ga.z, xn[i * 4 + 3] * rinv * ga.w);
      }
    } else {
      const float* ng = p.norm_mix_g + (l + 1) * 1024;
      const float* nsh = w.MODS + ((l + 1) * 2 + b) * 6144;
      const float* nsc = nsh + 1024;
      float y[16];
#pragma unroll
      for (int i = 0; i < 4; ++i) {
        *(uint2*)(w.X + (size_t)t * D + c0 + i * 4) = make_uint2(packh2(xn[i * 4], xn[i * 4 + 1]), packh2(xn[i * 4 + 2], xn[i * 4 + 3]));
        const float4 ga = *(const float4*)(ng + c0 + i * 4), sc = *(const float4*)(nsc + c0 + i * 4), sh = *(const float4*)(nsh + c0 + i * 4);
        y[i * 4 + 0] = xn[i * 4 + 0] * rinv * ga.x * (1.f + sc.x) + sh.x; y[i * 4 + 1] = xn[i * 4 + 1] * rinv * ga.y * (1.f + sc.y) + sh.y;
        y[i * 4 + 2] = xn[i * 4 + 2] * rinv * ga.z * (1.f + sc.z) + sh.z; y[i * 4 + 3] = xn[i * 4 + 3] * rinv * ga.w * (1.f + sc.w) + sh.w;
      }
      u32x4 o0, o1;
      o0.x = pack2(y[0], y[1]); o0.y = pack2(y[2], y[3]); o0.z = pack2(y[4], y[5]); o0.w = pack2(y[6], y[7]);
      o1.x = pack2(y[8], y[9]); o1.y = pack2(y[10], y[11]); o1.z = pack2(y[12], y[13]); o1.w = pack2(y[14], y[15]);
      *(u32x4*)(w.H + (size_t)t * D + c0) = o0; *(u32x4*)(w.H + (size_t)t * D + c0 + 8) = o1;
      if (l == 1) {
        bf16_t* HKV = (bf16_t*)(w.scr + SB_HKV);
        const float* ksh = w.KVMODS + b * 2048; const float* ksc = ksh + 1024;
#pragma unroll
        for (int i = 0; i < 4; ++i) {
          const float4 ga = *(const float4*)(p.kv_norm_g + c0 + i * 4), sc = *(const float4*)(ksc + c0 + i * 4), sh = *(const float4*)(ksh + c0 + i * 4);
          y[i * 4 + 0] = xn[i * 4 + 0] * rinv * ga.x * (1.f + sc.x) + sh.x; y[i * 4 + 1] = xn[i * 4 + 1] * rinv * ga.y * (1.f + sc.y) + sh.y;
          y[i * 4 + 2] = xn[i * 4 + 2] * rinv * ga.z * (1.f + sc.z) + sh.z; y[i * 4 + 3] = xn[i * 4 + 3] * rinv * ga.w * (1.f + sc.w) + sh.w;
        }
        o0.x = pack2(y[0], y[1]); o0.y = pack2(y[2], y[3]); o0.z = pack2(y[4], y[5]); o0.w = pack2(y[6], y[7]);
        o1.x = pack2(y[8], y[9]); o1.y = pack2(y[10], y[11]); o1.z = pack2(y[12], y[13]); o1.w = pack2(y[14], y[15]);
        *(u32x4*)(HKV + (size_t)t * D + c0) = o0; *(u32x4*)(HKV + (size_t)t * D + c0 + 8) = o1;
      }
    }
  }
}
DI void phase_down(const WS& w, int l, char* smem) {
  float* KVRAW = (float*)(w.scr + SB_KVRAW); float* QLRAW = (float*)(w.scr + SB_QLRAW);
  const bf16_t* HKV = (const bf16_t*)(w.scr + SB_HKV);
  for (int pass = (l == 2) ? 0 : 1; pass < 2; ++pass) {
    const bool kv = (pass == 0);
    const bf16_t* A = kv ? HKV : w.H;
    const bf16_t* Wt = kv ? (w.W + W_DKV) : (w.W + W_DQ + (size_t)(l - 2) * 384 * 1024);
    float* O = kv ? KVRAW : QLRAW;
    for (int it = blockIdx.x; it < 384 + (int)gridDim.x; it += gridDim.x) {
      int mt, nt;
      if (!xcd_item(it, 3, mt, nt)) break;
      const int m0 = mt * 128, n0 = nt * 128;
      f32x16 acc[2][2];
      gemm_tile(A + (size_t)m0 * D, D, Wt + (size_t)n0 * D, D, D, (bf16_t*)smem, acc);
      EPI_BEGIN O[(size_t)(m0 + trow) * 384 + n0 + tcol] = val; EPI_END
    }
  }
}
DI void phase_lnorm(const Params& p, const WS& w, int l) {
  const int lane = TIDX() & 63, wave = TIDX() >> 6;
  const int nkv = (l == 2) ? T / 4 : 0;
  const float* KVRAW = (const float*)(w.scr + SB_KVRAW); const float* QLRAW = (const float*)(w.scr + SB_QLRAW);
  bf16_t* CKV = (bf16_t*)(w.scr + SB_CKV); bf16_t* KR = (bf16_t*)(w.scr + SB_KR); bf16_t* QL = (bf16_t*)(w.scr + SB_QL);
  for (int it0 = blockIdx.x; it0 < nkv + T / 4; it0 += gridDim.x) {
    if (it0 < nkv) {
      const int t = it0 * 4 + wave;
      const float* rr = KVRAW + (size_t)t * 384;
      const float4 v = *(const float4*)(rr + lane * 4);
      float ss = wave_sum(v.x * v.x + v.y * v.y + v.z * v.z + v.w * v.w);
      const float rinv = rsqrtf(ss * (1.f / 256.f) + 1e-6f);
      const float4 gg = *(const float4*)(p.kv_latent_g + lane * 4);
      *(uint2*)(CKV + (size_t)t * 256 + lane * 4) = make_uint2(pack2(v.x * rinv * gg.x, v.y * rinv * gg.y), pack2(v.z * rinv * gg.z, v.w * rinv * gg.w));
      if (lane < 16) {
        const float x1 = rr[256 + lane], x2 = rr[272 + lane];
        const float ang = (float)p.pos[t] * ROPE_FREQ[lane];
        float sn, cs; rope_sincos(ang, sn, cs);
        KR[(size_t)t * 32 + lane] = f2bf(x1 * cs - x2 * sn);
        KR[(size_t)t * 32 + 16 + lane] = f2bf(x1 * sn + x2 * cs);
      }
    } else {
      const int t = (it0 - nkv) * 4 + wave;
      const float* rr = QLRAW + (size_t)t * 384;
      float2 v[3]; float ss = 0.f;
#pragma unroll
      for (int i = 0; i < 3; ++i) { v[i] = *(const float2*)(rr + i * 128 + lane * 2); ss += v[i].x * v[i].x + v[i].y * v[i].y; }
      ss = wave_sum(ss);
      const float rinv = rsqrtf(ss * (1.f / 384.f) + 1e-6f);
      const float* gq = p.q_latent_g + (l - 2) * 384;
#pragma unroll
      for (int i = 0; i < 3; ++i) {
        const int col = i * 128 + lane * 2;
        *(unsigned*)(QL + (size_t)t * 384 + col) = pack2(v[i].x * rinv * gq[col], v[i].y * rinv * gq[col + 1]);
      }
    }
  }
}
DI void phase_up(const WS& w, int l, char* smem) {
  const bf16_t* CKV = (const bf16_t*)(w.scr + SB_CKV); const bf16_t* QL = (const bf16_t*)(w.scr + SB_QL);
  bf16_t* KN = (bf16_t*)(w.scr + SB_KN); bf16_t* VT = (bf16_t*)(w.scr + SB_VT); bf16_t* QM = (bf16_t*)(w.scr + SB_QM);
  const bf16_t* UKV = w.W + W_UKV; const bf16_t* UQ = w.W + W_UQ + (size_t)(l - 2) * 1536 * 384;
  if (l == 2) {
    for (int it = blockIdx.x; it < 2048 + (int)gridDim.x; it += gridDim.x) {
      int mt, nt16;
      if (!xcd_item(it, 16, mt, nt16)) break;
      const int m0 = mt * 128, n0 = (nt16 & 7) * 128;
      f32x16 acc[2][2];
      if (nt16 < 8) {
        gemm_tile(CKV + (size_t)m0 * 256, 256, UKV + (size_t)n0 * 256, 256, 256, (bf16_t*)smem, acc);
        EPI_BEGIN KN[(size_t)(m0 + trow) * D + n0 + tcol] = f2bf(val); EPI_END
      } else {
        gemm_tile(UKV + (size_t)(1024 + n0) * 256, 256, CKV + (size_t)m0 * 256, 256, 256, (bf16_t*)smem, acc);
        const int b = m0 >> 13, s0 = m0 & (SEQ - 1);
        EPI_BEGIN VT[((size_t)b * 1024 + n0 + trow) * SEQ + s0 + tcol] = f2bf(val); EPI_END
      }
    }
  }
  for (int it = blockIdx.x; it < 1536 + (int)gridDim.x; it += gridDim.x) {
    int mt, nt;
    if (!xcd_item(it, 12, mt, nt)) break;
    const int m0 = mt * 128, n0 = nt * 128;
    f32x16 acc[2][2];
    gemm_tile(QL + (size_t)m0 * 384, 384, UQ + (size_t)n0 * 384, 384, 384, (bf16_t*)smem, acc);
    EPI_BEGIN QM[(size_t)(m0 + trow) * 1536 + n0 + tcol] = f2bf(val); EPI_END
  }
}
#define KS_ 104
#define VS_ 72
DI void phase_attn(const Params& p, const WS& w, char* smem) {
  bf16_t* sK = (bf16_t*)smem;
  bf16_t* sV = sK + 2 * 64 * KS_;
  const bf16_t* KN = (const bf16_t*)(w.scr + SB_KN); const bf16_t* VT = (const bf16_t*)(w.scr + SB_VT);
  const bf16_t* KR = (const bf16_t*)(w.scr + SB_KR); const bf16_t* QM = (const bf16_t*)(w.scr + SB_QM);
  bf16_t* AO = (bf16_t*)(w.scr + SB_AO);
  const int tid = TIDX(), lane = tid & 63, wave = tid >> 6, r = lane & 31, h = lane >> 5;
  const int pr = (r & 19) | ((r & 4) << 1) | ((r & 8) >> 1);
  const int G = gridDim.x;
  const float QSC = 0.10206207261596575f * 1.4426950408889634f;
  for (int idx = blockIdx.x; idx < 2048; idx += G) {
    const int rnd = idx / G, jj = idx - rnd * G;
    int qt, bh;
    if (G == 512) {
      const int xcd = jj & 7, slot = jj >> 3;
      bh = xcd + 8 * rnd;
      qt = (rnd & 1) ? slot : (63 - slot);
    } else {
      const int spos = ((rnd & 1) && ((rnd + 1) * G <= 2048)) ? (rnd * G + (G - 1 - jj)) : idx;
      qt = 63 - (spos >> 5); bh = spos & 31;
    }
    const int b = bh >> 4, hd = bh & 15;
    const int q0 = qt * 128, tok0 = b * SEQ;
    const int qrow = tok0 + q0 + wave * 32 + r;
    const int qposi = p.pos[qrow];
    bf16x8 qf[6];
    {
      const bf16_t* qp = QM + (size_t)qrow * 1536 + hd * 96 + h * 8;
      uint4 qr[6];
#pragma unroll
      for (int ks = 0; ks < 6; ++ks) qr[ks] = *(const uint4*)(qp + ks * 16);
#pragma unroll
      for (int ks = 0; ks < 4; ++ks) {
        uint4 o;
        o.x = pack2(bflo(qr[ks].x) * QSC, bfhi(qr[ks].x) * QSC); o.y = pack2(bflo(qr[ks].y) * QSC, bfhi(qr[ks].y) * QSC);
        o.z = pack2(bflo(qr[ks].z) * QSC, bfhi(qr[ks].z) * QSC); o.w = pack2(bflo(qr[ks].w) * QSC, bfhi(qr[ks].w) * QSC);
        qf[ks] = __builtin_bit_cast(bf16x8, o);
      }
      float x1[8], x2[8], o1[8], o2[8];
      x1[0] = bflo(qr[4].x); x1[1] = bfhi(qr[4].x); x1[2] = bflo(qr[4].y); x1[3] = bfhi(qr[4].y);
      x1[4] = bflo(qr[4].z); x1[5] = bfhi(qr[4].z); x1[6] = bflo(qr[4].w); x1[7] = bfhi(qr[4].w);
      x2[0] = bflo(qr[5].x); x2[1] = bfhi(qr[5].x); x2[2] = bflo(qr[5].y); x2[3] = bfhi(qr[5].y);
      x2[4] = bflo(qr[5].z); x2[5] = bfhi(qr[5].z); x2[6] = bflo(qr[5].w); x2[7] = bfhi(qr[5].w);
      const float fpos = (float)qposi;
#pragma unroll
      for (int j = 0; j < 8; ++j) {
        const float ang = fpos * ROPE_FREQ[h * 8 + j];
        float sn, cs; rope_sincos(ang, sn, cs);
        o1[j] = (x1[j] * cs - x2[j] * sn) * QSC; o2[j] = (x1[j] * sn + x2[j] * cs) * QSC;
      }
      uint4 o;
      o.x = pack2(o1[0], o1[1]); o.y = pack2(o1[2], o1[3]); o.z = pack2(o1[4], o1[5]); o.w = pack2(o1[6], o1[7]);
      qf[4] = __builtin_bit_cast(bf16x8, o);
      o.x = pack2(o2[0], o2[1]); o.y = pack2(o2[2], o2[3]); o.z = pack2(o2[4], o2[5]); o.w = pack2(o2[6], o2[7]);
      qf[5] = __builtin_bit_cast(bf16x8, o);
    }
    const int nt = 2 * (qt + 1);
    const int kkey = tid >> 3, kch = tid & 7;
    const int rkey = tid >> 2, rch = tid & 3;
    const bf16_t* gKN = KN + (size_t)(tok0 + kkey) * D + hd * 64 + kch * 8;
    const bf16_t* gKR = KR + (size_t)(tok0 + rkey) * 32 + rch * 8;
    const bf16_t* gVT = VT + ((size_t)bh * 64 + kkey) * SEQ + kch * 8;
    bf16_t* sVV = sK + 2 * 64 * KS_;
    u32x4 Gk0, Gk1, Gr, Gv0, Gv1;
#define ALOAD(KT)                                                            \
    {                                                                        \
      const size_t k1 = (size_t)(KT) * 64;                                   \
      Gk0 = *(const u32x4*)(gKN + k1 * D); Gk1 = *(const u32x4*)(gKN + (k1 + 32) * D); \
      Gr = *(const u32x4*)(gKR + k1 * 32);                                   \
      Gv0 = *(const u32x4*)(gVT + k1); Gv1 = *(const u32x4*)(gVT + (size_t)32 * SEQ + k1); \
    }
#define ASTORE(KB, VB)                                                       \
    {                                                                        \
      bf16_t* nK = sK + (KB) * 64 * KS_; bf16_t* nV = sVV + (VB) * 64 * VS_; \
      *(u32x4*)(nK + kkey * KS_ + kch * 8) = Gk0; *(u32x4*)(nK + (kkey + 32) * KS_ + kch * 8) = Gk1; \
      *(u32x4*)(nK + rkey * KS_ + 64 + rch * 8) = Gr;                        \
      *(u32x4*)(nV + kkey * VS_ + kch * 8) = Gv0; *(u32x4*)(nV + (kkey + 32) * VS_ + kch * 8) = Gv1; \
    }
#define QK_TILE(ST, KB, KT)                                                  \
    {                                                                        \
      const bf16_t* cK = sK + (KB) * 64 * KS_;                               \
      _Pragma("unroll") for (int q = 0; q < 16; ++q) { ST[0][q] = 0.f; ST[1][q] = 0.f; } \
      _Pragma("unroll") for (int kb = 0; kb < 2; ++kb)                       \
      _Pragma("unroll") for (int ks = 0; ks < 6; ++ks) {                     \
        const bf16x8 a = *(const bf16x8*)(cK + (32 * kb + pr) * KS_ + ks * 16 + h * 8); \
        ST[kb] = MFMA(a, qf[ks], ST[kb]);                                    \
      }                                                                      \
      if ((KT) >= nt - 2) {                                                  \
        const int kbase = tok0 + (KT) * 64 + 8 * h;                          \
        _Pragma("unroll") for (int kb = 0; kb < 2; ++kb)                     \
        _Pragma("unroll") for (int g2 = 0; g2 < 2; ++g2) {                   \
          const int4 pa = *(const int4*)(p.pos + kbase + 32 * kb + 16 * g2), pb = *(const int4*)(p.pos + kbase + 32 * kb + 16 * g2 + 4); \
          if (pa.x > qposi) ST[kb][g2 * 8 + 0] = -1e30f; if (pa.y > qposi) ST[kb][g2 * 8 + 1] = -1e30f; \
          if (pa.z > qposi) ST[kb][g2 * 8 + 2] = -1e30f; if (pa.w > qposi) ST[kb][g2 * 8 + 3] = -1e30f; \
          if (pb.x > qposi) ST[kb][g2 * 8 + 4] = -1e30f; if (pb.y > qposi) ST[kb][g2 * 8 + 5] = -1e30f; \
          if (pb.z > qposi) ST[kb][g2 * 8 + 6] = -1e30f; if (pb.w > qposi) ST[kb][g2 * 8 + 7] = -1e30f; \
        }                                                                    \
      }                                                                      \
    }
#define SOFTMAX_PV(ST, VB)                                                   \
    {                                                                        \
      const bf16_t* cV = sVV + (VB) * 64 * VS_;                              \
      float mx = ST[0][0];                                                   \
      _Pragma("unroll") for (int q = 1; q < 16; ++q) mx = fmaxf(mx, ST[0][q]); \
      _Pragma("unroll") for (int q = 0; q < 16; ++q) mx = fmaxf(mx, ST[1][q]); \
      mx = swap32_max(mx);                                    \
      if (__builtin_amdgcn_ballot_w64(mx > mrun + 6.f) != 0ull) {            \
        const float mnew = fmaxf(mrun, mx);                                  \
        const float alpha = __builtin_amdgcn_exp2f(mrun - mnew);             \
        mrun = mnew; lsum *= alpha;                                          \
        _Pragma("unroll") for (int q = 0; q < 16; ++q) { ot[0][q] *= alpha; ot[1][q] *= alpha; } \
      }                                                                      \
      bf16x8 pf[2][2];                                                       \
      _Pragma("unroll") for (int kb = 0; kb < 2; ++kb) {                     \
        float pv[16];                                                        \
        _Pragma("unroll") for (int q = 0; q < 16; ++q) { pv[q] = __builtin_amdgcn_exp2f(ST[kb][q] - mrun); lsum += pv[q]; } \
        _Pragma("unroll") for (int s2 = 0; s2 < 2; ++s2) {                   \
          u32x4 o;                                                           \
          o.x = pack2(pv[8 * s2 + 0], pv[8 * s2 + 1]); o.y = pack2(pv[8 * s2 + 2], pv[8 * s2 + 3]); \
          o.z = pack2(pv[8 * s2 + 4], pv[8 * s2 + 5]); o.w = pack2(pv[8 * s2 + 6], pv[8 * s2 + 7]); \
          pf[kb][s2] = __builtin_bit_cast(bf16x8, o);                        \
        }                                                                    \
      }                                                                      \
      _Pragma("unroll") for (int db = 0; db < 2; ++db)                       \
      _Pragma("unroll") for (int kb = 0; kb < 2; ++kb)                       \
      _Pragma("unroll") for (int s2 = 0; s2 < 2; ++s2) {                     \
        const bf16x8 a = *(const bf16x8*)(cV + (32 * db + r) * VS_ + 32 * kb + 16 * s2 + 8 * h); \
        ot[db] = MFMA(a, pf[kb][s2], ot[db]);                                \
      }                                                                      \
    }
#define FAST_STEP(SC, SN, KB, VB)                                            \
    {                                                                        \
      const bf16_t* cK = sK + (KB) * 64 * KS_;                               \
      const bf16_t* cV = sVV + (VB) * 64 * VS_;                              \
      float mx = SC[0][0];                                                   \
      _Pragma("unroll") for (int q = 1; q < 16; ++q) mx = fmaxf(mx, SC[0][q]); \
      _Pragma("unroll") for (int q = 0; q < 16; ++q) mx = fmaxf(mx, SC[1][q]); \
      mx = swap32_max(mx);                                    \
      if (__builtin_amdgcn_ballot_w64(mx > mrun + 6.f) != 0ull) {            \
        const float mnew = fmaxf(mrun, mx);                                  \
        const float alpha = __builtin_amdgcn_exp2f(mrun - mnew);             \
        mrun = mnew; lsum *= alpha;                                          \
        _Pragma("unroll") for (int q = 0; q < 16; ++q) { ot[0][q] *= alpha; ot[1][q] *= alpha; } \
      }                                                                      \
      _Pragma("unroll") for (int q = 0; q < 16; ++q) { SN[0][q] = 0.f; SN[1][q] = 0.f; } \
      float pv[32];                                                          \
      bf16x8 kf[12];                                                         \
      _Pragma("unroll") for (int st0 = 0; st0 < 3; ++st0) kf[st0] = *(const bf16x8*)(cK + (32 * (st0 & 1) + pr) * KS_ + (st0 >> 1) * 16 + h * 8); \
      __builtin_amdgcn_sched_barrier(0);                                     \
      _Pragma("unroll") for (int step = 0; step < 12; ++step) {              \
        const int kb = step & 1, ks = step >> 1;                             \
        if (step + 3 < 12) kf[step + 3] = *(const bf16x8*)(cK + (32 * ((step + 3) & 1) + pr) * KS_ + ((step + 3) >> 1) * 16 + h * 8); \
        SN[kb] = MFMA(kf[step], qf[ks], SN[kb]);                             \
        const int e0 = (step < 8) ? 3 * step : 24 + 2 * (step - 8);          \
        const int ne = (step < 8) ? 3 : 2;                                   \
        _Pragma("unroll") for (int e = 0; e < 3; ++e) if (e < ne) {          \
          const int ee = e0 + e;                                             \
          pv[ee] = __builtin_amdgcn_exp2f(SC[ee >> 4][ee & 15] - mrun); lsum += pv[ee]; \
        }                                                                    \
        __builtin_amdgcn_sched_barrier(0);                                   \
      }                                                                      \
      _Pragma("unroll") for (int kb = 0; kb < 2; ++kb)                       \
      _Pragma("unroll") for (int s2 = 0; s2 < 2; ++s2) {                     \
        u32x4 o;                                                             \
        const int b0 = kb * 16 + 8 * s2;                                     \
        o.x = pack2(pv[b0 + 0], pv[b0 + 1]); o.y = pack2(pv[b0 + 2], pv[b0 + 3]); \
        o.z = pack2(pv[b0 + 4], pv[b0 + 5]); o.w = pack2(pv[b0 + 6], pv[b0 + 7]); \
        const bf16x8 pfr = __builtin_bit_cast(bf16x8, o);                    \
        _Pragma("unroll") for (int db = 0; db < 2; ++db) {                   \
          const bf16x8 a = *(const bf16x8*)(cV + (32 * db + r) * VS_ + 32 * kb + 16 * s2 + 8 * h); \
          ot[db] = MFMA(a, pfr, ot[db]);                                     \
        }                                                                    \
      }                                                                      \
    }
    const int ntl = nt - 1;
    f32x16 ot[2];
#pragma unroll
    for (int q = 0; q < 16; ++q) { ot[0][q] = 0.f; ot[1][q] = 0.f; }
    float mrun = -1e30f, lsum = 0.f;
    f32x16 stA[2], stB[2];
    ALOAD(0)
    ASTORE(0, 0)
    ALOAD(1)
    __syncthreads();
    QK_TILE(stA, 0, 0)
    ASTORE(1, 1)
    __syncthreads();
    int vb = 0;
    int kt = 0;
    for (; kt + 4 < nt; kt += 2) {
      {
        ALOAD(kt + 2)
        FAST_STEP(stA, stB, 1, vb)
        const int vb2 = (vb == 0) ? 2 : (vb - 1);
        ASTORE(0, vb2)
        __syncthreads();
        vb = (vb == 2) ? 0 : (vb + 1);
      }
      {
        ALOAD(kt + 3)
        FAST_STEP(stB, stA, 0, vb)
        const int vb2 = (vb == 0) ? 2 : (vb - 1);
        ASTORE(1, vb2)
        __syncthreads();
        vb = (vb == 2) ? 0 : (vb + 1);
      }
    }
    for (; kt < nt; kt += 2) {
      {
        const int kn = (kt + 2 < nt) ? (kt + 2) : ntl;
        ALOAD(kn)
        const int k1t = (kt + 1 < nt) ? (kt + 1) : ntl;
        QK_TILE(stB, 1, k1t)
        SOFTMAX_PV(stA, vb)
        const int vb2 = (vb == 0) ? 2 : (vb - 1);
        ASTORE(0, vb2)
        __syncthreads();
        vb = (vb == 2) ? 0 : (vb + 1);
      }
      {
        const int kn = (kt + 3 < nt) ? (kt + 3) : ntl;
        ALOAD(kn)
        const int k1t = (kt + 2 < nt) ? (kt + 2) : ntl;
        QK_TILE(stA, 0, k1t)
        SOFTMAX_PV(stB, vb)
        const int vb2 = (vb == 0) ? 2 : (vb - 1);
        ASTORE(1, vb2)
        __syncthreads();
        vb = (vb == 2) ? 0 : (vb + 1);
      }
    }
#undef ALOAD
#undef ASTORE
#undef QK_TILE
#undef SOFTMAX_PV
#undef FAST_STEP
    lsum += __shfl_xor(lsum, 32);
    const float inv = 1.f / lsum;
    bf16_t* op = AO + (size_t)qrow * D + hd * 64;
#pragma unroll
    for (int db = 0; db < 2; ++db)
#pragma unroll
      for (int g4 = 0; g4 < 4; ++g4) {
        const int d = 32 * db + 8 * g4 + 4 * h;
        *(uint2*)(op + d) = make_uint2(pack2(ot[db][g4 * 4] * inv, ot[db][g4 * 4 + 1] * inv), pack2(ot[db][g4 * 4 + 2] * inv, ot[db][g4 * 4 + 3] * inv));
      }
  }
}


#define XB_TMO      128
#define XB_XCNT(j)  (256  + 64 * (j))
#define XB_XSUB(j)  (1280 + 64 * (j))
#define XB_XGEN(j)  (2304 + 64 * (j))
#define XB_TOP      3328
#define XB_TOPGEN   3392
#define XCD_BAR_WORDS 3456
#define XB_SPIN_CAP (1u << 18)
#define LAS __attribute__((address_space(3)))
DI unsigned xb_ld(unsigned* p) { return __hip_atomic_load(p, __ATOMIC_RELAXED, __HIP_MEMORY_SCOPE_AGENT); }
DI unsigned xb_add(unsigned* p, unsigned v) { return __hip_atomic_fetch_add(p, v, __ATOMIC_RELAXED, __HIP_MEMORY_SCOPE_AGENT); }
DI unsigned xb_xcc_id() { return (unsigned)__builtin_amdgcn_s_getreg((3 << 11) | 20) & 0xFu; }
#define XB_SPIN(cond, bar) do { unsigned _sp = 0; while (cond) { __builtin_amdgcn_s_sleep(1); \
    if ((++_sp & 255u) == 0u) { if (xb_ld(&(bar)[XB_TMO])) break; if (_sp > XB_SPIN_CAP) { atomicAdd(&(bar)[XB_TMO], 1u); break; } } } } while (0)
struct XcdBarrier { unsigned* bar; unsigned x; volatile LAS unsigned* st; };
DI XcdBarrier xcd_barrier_post(unsigned* bar, volatile LAS unsigned* st) {
  XcdBarrier b; b.bar = bar; b.x = xb_xcc_id(); b.st = st;
  if (__builtin_amdgcn_workitem_id_x() == 0) (void)xb_add(&bar[XB_XCNT(b.x)], 1u);
  return b;
}
DI void xcd_barrier_complete(unsigned* bar, unsigned x, unsigned& nloc, unsigned& nx) {
  const unsigned G = gridDim.x;
  unsigned sum, cnt, mine, sp = 0u;
  for (;;) {
    sum = 0u; cnt = 0u; mine = 0u;
#pragma unroll
    for (unsigned j = 0; j < 16; ++j) { const unsigned c = xb_ld(&bar[XB_XCNT(j)]); sum += c; cnt += (c > 0u) ? 1u : 0u; mine = (j == x) ? c : mine; }
    if (sum == G) break;
    __builtin_amdgcn_s_sleep(1);
    if ((++sp & 255u) == 0u) { if (xb_ld(&bar[XB_TMO])) break; if (sp > XB_SPIN_CAP) { atomicAdd(&bar[XB_TMO], 1u); break; } }
  }
  nloc = mine > 0u ? mine : 1u; nx = cnt > 0u ? cnt : 1u;
}
DI void xcd_barrier(const XcdBarrier& b) {
  asm volatile("s_waitcnt vmcnt(0)" ::: "memory");
  __syncthreads();
  if (__builtin_amdgcn_workitem_id_x() == 0) {
    unsigned* bar = b.bar;
    __builtin_amdgcn_s_waitcnt(0);
    unsigned nloc = b.st[0], nx = b.st[1];
    if (nloc == 0u) { xcd_barrier_complete(bar, b.x, nloc, nx); b.st[0] = nloc; b.st[1] = nx; }
    const unsigned old = xb_add(&bar[XB_XSUB(b.x)], 1u);
    const unsigned gen = old / nloc;
    if (old + 1u == (gen + 1u) * nloc) {
      __builtin_amdgcn_fence(__ATOMIC_RELEASE, "agent");
      asm volatile("s_waitcnt vmcnt(0)" ::: "memory");
      const unsigned og = xb_add(&bar[XB_TOP], 1u);
      const unsigned tg = og / nx;
      if (og + 1u == (tg + 1u) * nx) xb_add(&bar[XB_TOPGEN], 1u);
      else XB_SPIN(xb_ld(&bar[XB_TOPGEN]) == tg, bar);
      __builtin_amdgcn_fence(__ATOMIC_ACQUIRE, "agent");
      xb_add(&bar[XB_XGEN(b.x)], 1u);
      asm volatile("s_waitcnt vmcnt(0)" ::: "memory");
    } else {
      XB_SPIN(xb_ld(&bar[XB_XGEN(b.x)]) == gen, bar);
      __builtin_amdgcn_fence(__ATOMIC_ACQUIRE, "agent");
      asm volatile("s_waitcnt vmcnt(0)" ::: "memory");
    }
  }
  __syncthreads();
}

enum { OP_PREP = 0, OP_NORM0, OP_WIN, OP_CONV, OP_GATES, OP_SCAN1, OP_SCAN2, OP_OUTPROJ, OP_FFNNORM, OP_PEERQ, OP_TOPK, OP_EXP,
       OP_DOWN, OP_LNORM, OP_UP, OP_ATTN };
constexpr int NPH = 34;
__device__ const unsigned char PROG[NPH][2] = {
  {OP_PREP, 0}, {OP_NORM0, 0},
  {OP_WIN, 0}, {OP_CONV, 0}, {OP_GATES, 0}, {OP_SCAN2, 0}, {OP_OUTPROJ, 0}, {OP_FFNNORM, 0}, {OP_TOPK, 0}, {OP_EXP, 0},
  {OP_WIN, 1}, {OP_CONV, 1}, {OP_GATES, 1}, {OP_SCAN2, 1}, {OP_OUTPROJ, 1}, {OP_FFNNORM, 1}, {OP_TOPK, 1}, {OP_EXP, 1},
  {OP_DOWN, 2}, {OP_LNORM, 2}, {OP_UP, 2}, {OP_ATTN, 2}, {OP_OUTPROJ, 2}, {OP_FFNNORM, 2}, {OP_TOPK, 2}, {OP_EXP, 2},
  {OP_DOWN, 3}, {OP_LNORM, 3}, {OP_UP, 3}, {OP_ATTN, 3}, {OP_OUTPROJ, 3}, {OP_FFNNORM, 3}, {OP_TOPK, 3}, {OP_EXP, 3}};

template <bool COOP>
__global__ void __launch_bounds__(256, 2) yoco_mega(Params p, int lo, int hi) {
  __shared__ __attribute__((aligned(16))) char smem[SMEM_TOTAL];
  const WS w = make_ws(p.ws);
  if (TIDX() == 0) {
    TJob* sj = (TJob*)(smem + SMEM_MAIN);
#pragma unroll
    for (int q = 0; q < NJOBS; ++q) sj[q] = p.jobs[q];
    *(uint4*)(smem + SMEM_MAIN + 2032) = make_uint4(0u, 0u, 0u, 0u);
  }
  __syncthreads();
  XcdBarrier xb;
  if (COOP) xb = xcd_barrier_post((unsigned*)(p.ws + OFF_BAR), (volatile LAS unsigned*)(smem + SMEM_MAIN + 2032));
  if (COOP && hi > 100000) cg::this_grid().sync();
  for (int ph = lo; ph < hi; ++ph) {
    const int op = PROG[ph][0], l = PROG[ph][1];
    const int nrep = ((REPMASK >> op) & 1) ? 2 : 1;
    for (int rep = 0; rep < nrep; ++rep)
    switch (op) {
      case OP_PREP: if ((OPMASK >> OP_PREP) & 1) { phase_prep(p, w, smem); } break;
      case OP_NORM0: if ((OPMASK >> OP_NORM0) & 1) { phase_norm_rows<false>(p.x, p.norm_mix_g, w.MODS, w.MODS + 1024, 6144, w.H); } break;
      case OP_WIN: if ((OPMASK >> OP_WIN) & 1) { phase_win(p, w, l, smem); } break;
      case OP_CONV: if ((OPMASK >> OP_CONV) & 1) { phase_conv(p, w, l); } break;
      case OP_GATES: if ((OPMASK >> OP_GATES) & 1) { phase_gates(p, w, l, smem); } break;
      case OP_SCAN1: if ((OPMASK >> OP_SCAN1) & 1) { phase_scan1(w); } break;
      case OP_SCAN2: if ((OPMASK >> OP_SCAN2) & 1) { phase_scan2(w); } break;
      case OP_OUTPROJ: if ((OPMASK >> OP_OUTPROJ) & 1) { phase_outproj(p, w, l, smem, rep > 0); } break;
      case OP_FFNNORM: if ((OPMASK >> OP_FFNNORM) & 1) { phase_norm_rows<true>(w.X, p.norm_ffn_g + l * 1024, w.MODS + l * 2 * 6144 + 3072, w.MODS + l * 2 * 6144 + 4096, 6144, w.H); } break;
      case OP_PEERQ: if ((OPMASK >> OP_PEERQ) & 1) { phase_peerq(w, l, smem); } break;
      case OP_TOPK: if ((OPMASK >> OP_TOPK) & 1) { phase_topk(p, w, l, smem); } break;
      case OP_EXP: if ((OPMASK >> OP_EXP) & 1) { phase_exp(p, w, l, rep > 0); } break;
      case OP_DOWN: if ((OPMASK >> OP_DOWN) & 1) { phase_down(w, l, smem); } break;
      case OP_LNORM: if ((OPMASK >> OP_LNORM) & 1) { phase_lnorm(p, w, l); } break;
      case OP_UP: if ((OPMASK >> OP_UP) & 1) { phase_up(w, l, smem); } break;
      case OP_ATTN: if ((OPMASK >> OP_ATTN) & 1) { phase_attn(p, w, smem); } break;
      default: break;
    }
    if (COOP) { if (ph + 1 < hi) { xcd_barrier(xb); for (int q = 0; q < SYNCX; ++q) xcd_barrier(xb); } }
  }
}

static void add_job(Params& P, int& nj, int& tile, const float* src, bf16_t* dst, int K, int N, int ldd, int mode, int rowbase) {
  TJob& j = P.jobs[nj++];
  j.src = src; j.dst = dst; j.K = K; j.N = N; j.ldd = ldd; j.mode = mode; j.rowbase = rowbase; j.tile0 = tile;
  j.ntiles = (K / 64) * ((N + 63) / 64); j.pad = 0; tile += j.ntiles;
}

extern "C" void kernel_launch(void* const* d_in, const int* in_sizes, int n_in, void* d_out, int out_size, void* d_ws, size_t ws_size,
                              hipStream_t stream) {
  static Params P;
  memset(&P, 0, sizeof(P));
  const float* const* f = (const float* const*)d_in;
  P.x = f[0]; P.c = f[1]; P.pos = (const int*)d_in[2];
  P.ada_w = f[3]; P.ada_b = f[4]; P.norm_mix_g = f[5]; P.norm_ffn_g = f[6];
  P.lru_w_in = f[7]; P.lru_conv_w = f[8]; P.lru_conv_b = f[9]; P.lru_wa = f[10]; P.lru_ba = f[11]; P.lru_wx = f[12]; P.lru_bx = f[13];
  P.lru_lambda = f[14]; P.lru_w_out = f[15];
  P.kv_ada_w = f[16]; P.kv_ada_b = f[17]; P.kv_norm_g = f[18]; P.w_dkv = f[19]; P.w_kr = f[20]; P.kv_latent_g = f[21]; P.w_uk = f[22]; P.w_uv = f[23];
  P.w_dq = f[24]; P.q_latent_g = f[25]; P.w_uq = f[26]; P.w_o = f[27];
  P.peer_w_q = f[28]; P.peer_keys = f[29]; P.peer_u = f[30]; P.peer_v = f[31]; P.final_g = f[32];
  P.out = (float*)d_out; P.ws = (char*)d_ws;
  bf16_t* W = (bf16_t*)((char*)d_ws + OFF_W);
  int nj = 0, tile = 0;
  for (int l = 0; l < 2; ++l) add_job(P, nj, tile, P.lru_w_in + (size_t)l * 1024 * 2048, W + W_WIN + (size_t)l * 2048 * 1024, 1024, 2048, 1024, 0, 0);
  for (int l = 0; l < 2; ++l)
    for (int hh = 0; hh < 4; ++hh) {
      add_job(P, nj, tile, P.lru_wa + (size_t)(l * 4 + hh) * 65536, W + W_GATE + (size_t)l * 2048 * 256, 256, 256, 256, 1, hh * 256);
      add_job(P, nj, tile, P.lru_wx + (size_t)(l * 4 + hh) * 65536, W + W_GATE + (size_t)l * 2048 * 256, 256, 256, 256, 2, hh * 256);
    }
  for (int l = 0; l < 2; ++l) add_job(P, nj, tile, P.lru_w_out + (size_t)l * 1024 * 1024, W + W_WOUT + (size_t)l * 1024 * 1024, 1024, 1024, 1024, 0, 0);
  add_job(P, nj, tile, P.w_dkv, W + W_DKV, 1024, 256, 1024, 0, 0);
  add_job(P, nj, tile, P.w_kr, W + W_DKV, 1024, 32, 1024, 0, 256);
  add_job(P, nj, tile, P.w_uk, W + W_UKV, 256, 1024, 256, 0, 0);
  add_job(P, nj, tile, P.w_uv, W + W_UKV, 256, 1024, 256, 0, 1024);
  for (int j = 0; j < 2; ++j) add_job(P, nj, tile, P.w_dq + (size_t)j * 1024 * 384, W + W_DQ + (size_t)j * 384 * 1024, 1024, 384, 1024, 0, 0);
  for (int j = 0; j < 2; ++j) add_job(P, nj, tile, P.w_uq + (size_t)j * 384 * 1536, W + W_UQ + (size_t)j * 1536 * 384, 384, 1536, 384, 0, 0);
  for (int j = 0; j < 2; ++j) add_job(P, nj, tile, P.w_o + (size_t)j * 1024 * 1024, W + W_WO + (size_t)j * 1024 * 1024, 1024, 1024, 1024, 0, 0);
  for (int l = 0; l < 4; ++l) add_job(P, nj, tile, P.peer_w_q + (size_t)l * 1024 * 2048, W + W_PQ + (size_t)l * 2048 * 1024, 1024, 2048, 1024, 0, 0);
  P.n_tconv = tile;
  static int grid_blocks = 0;
  if (!grid_blocks) {
    int dev = 0, cus = 0, per_cu = 0;
    hipGetDevice(&dev);
    hipDeviceGetAttribute(&cus, hipDeviceAttributeMultiprocessorCount, dev);
    hipOccupancyMaxActiveBlocksPerMultiprocessor(&per_cu, yoco_mega<true>, 256, 0);
    if (per_cu > 2) per_cu = 2;
    if (per_cu < 1) per_cu = 1;
    grid_blocks = cus * per_cu;
  }
#if MULTI
  for (int ph = 0; ph < NPH; ++ph) hipLaunchKernelGGL((yoco_mega<false>), dim3(grid_blocks), dim3(256), 0, stream, P, ph, ph + 1);
#else
  int lo = 0, hi = NPH;
  void* args[] = {&P, &lo, &hi};
  (void)hipMemsetAsync((char*)d_ws + OFF_BAR, 0, XCD_BAR_WORDS * 4, stream);
  hipError_t e = hipLaunchCooperativeKernel((void*)yoco_mega<true>, dim3(grid_blocks), dim3(256), args, 0, stream);
  if (e != hipSuccess) fprintf(stderr, "cooperative launch failed: %s (grid %d)\n", hipGetErrorString(e), grid_blocks);
#endif
}
```

```cpp
#include <hip/hip_runtime.h>
#include <hip/hip_cooperative_groups.h>
#include <stdint.h>
#include <string.h>
#include <stdio.h>
namespace cg = cooperative_groups;

#ifndef MULTI
#define MULTI 0
#endif
#ifndef REPMASK
#define REPMASK 0x0
#endif
#ifndef SYNCX
#define SYNCX 0
#endif
#ifndef OPMASK
#define OPMASK 0xFFFF
#endif

#define DI __device__ __forceinline__
DI int TIDX() { int t = (int)__builtin_amdgcn_workitem_id_x(); asm volatile("" : "+v"(t)); return t; }
typedef unsigned short bf16_t;
typedef __attribute__((ext_vector_type(8))) short bf16x8;
typedef __attribute__((ext_vector_type(16))) float f32x16;
typedef unsigned u32x4 __attribute__((ext_vector_type(4)));
typedef __bf16 bf16x2_t __attribute__((ext_vector_type(2)));
typedef float f32x2_t __attribute__((ext_vector_type(2)));
typedef _Float16 half_t;
typedef _Float16 h16x2_t __attribute__((ext_vector_type(2)));
#define MFMA(a, b, c) __builtin_amdgcn_mfma_f32_32x32x16_bf16((a), (b), (c), 0, 0, 0)

constexpr int T = 16384, D = 1024, SEQ = 8192;
constexpr size_t MB = 1048576;
constexpr size_t OFF_X = 0, OFF_H = 64 * MB, OFF_SCR = 96 * MB, OFF_QP = 352 * MB, OFF_PIDX = 416 * MB, OFF_PG = 424 * MB,
                 OFF_MODS = 432 * MB, OFF_SUM = 433 * MB, OFF_BAR = 435 * MB, OFF_W = 436 * MB, OFF_TU = 480 * MB, OFF_TV = 544 * MB, OFF_SU = 608 * MB, OFF_SV = 609 * MB;
constexpr size_t SA_G = 0, SA_REC = 32 * MB, SA_XC = 64 * MB, SA_AA = 96 * MB, SA_BB = 160 * MB, SA_YG = 224 * MB;
constexpr size_t SB_KN = 0, SB_VT = 32 * MB, SB_KR = 64 * MB, SB_CKV = 65 * MB, SB_KVRAW = 73 * MB, SB_HKV = 97 * MB,
                 SB_QLRAW = 129 * MB, SB_QL = 153 * MB, SB_QM = 165 * MB, SB_AO = 213 * MB;
constexpr size_t W_WIN = 0, W_GATE = W_WIN + 2 * 2048 * 1024, W_WOUT = W_GATE + 2 * 2048 * 256, W_DKV = W_WOUT + 2 * 1024 * 1024,
                 W_UKV = W_DKV + 384 * 1024, W_DQ = W_UKV + 2048 * 256, W_UQ = W_DQ + 2 * 384 * 1024, W_WO = W_UQ + 2 * 1536 * 384,
                 W_PQ = W_WO + 2 * 1024 * 1024, W_KEYS = W_PQ + 4 * 2048 * 1024, W_END = W_KEYS + 4 * 262144;
static_assert(W_END * 2 <= 44 * MB, "weights overflow");

constexpr int NJOBS = 34;
struct TJob { const float* src; bf16_t* dst; int K, N, ldd, mode, rowbase, tile0, ntiles, pad; };
struct Params {
  const float *x, *c; const int* pos;
  const float *ada_w, *ada_b, *norm_mix_g, *norm_ffn_g;
  const float *lru_w_in, *lru_conv_w, *lru_conv_b, *lru_wa, *lru_ba, *lru_wx, *lru_bx, *lru_lambda, *lru_w_out;
  const float *kv_ada_w, *kv_ada_b, *kv_norm_g, *w_dkv, *w_kr, *kv_latent_g, *w_uk, *w_uv;
  const float *w_dq, *q_latent_g, *w_uq, *w_o;
  const float *peer_w_q, *peer_keys, *peer_u, *peer_v, *final_g;
  float* out; char* ws;
  TJob jobs[NJOBS];
  int n_tconv, pad0;
};

constexpr int SMEM_MAIN = 73728;
constexpr int SMEM_TOTAL = SMEM_MAIN + 2048;

__device__ const float ROPE_FREQ[16] = {1.0f, 0.5623413251903491f, 0.31622776601683794f, 0.1778279410038923f,
  0.1f, 0.05623413251903491f, 0.031622776601683794f, 0.01778279410038923f, 0.01f, 0.005623413251903491f,
  0.0031622776601683794f, 0.001778279410038923f, 0.001f, 0.0005623413251903491f, 0.00031622776601683794f, 0.0001778279410038923f};

DI unsigned pack2(float a, float b) {
  f32x2_t v = {a, b};
  bf16x2_t r = __builtin_convertvector(v, bf16x2_t);
  return __builtin_bit_cast(unsigned, r);
}
DI bf16_t f2bf(float a) { return (bf16_t)(pack2(a, 0.f) & 0xffffu); }
DI float bflo(unsigned u) { return __uint_as_float(u << 16); }
DI float bfhi(unsigned u) { return __uint_as_float(u & 0xffff0000u); }
DI float bf2f(bf16_t b) { return __uint_as_float(((unsigned)b) << 16); }
DI float hlo(unsigned u) { return (float)__builtin_bit_cast(h16x2_t, u).x; }
DI float hhi(unsigned u) { return (float)__builtin_bit_cast(h16x2_t, u).y; }
DI unsigned packh2(float a, float b) { h16x2_t v = {(half_t)a, (half_t)b}; return __builtin_bit_cast(unsigned, v); }
DI float dot2(unsigned a, unsigned b, float c) {
  return __builtin_amdgcn_fdot2_f32_bf16(__builtin_bit_cast(bf16x2_t, a), __builtin_bit_cast(bf16x2_t, b), c, false);
}
DI float wave_sum(float v) {
#pragma unroll
  for (int o = 32; o > 0; o >>= 1) v += __shfl_xor(v, o);
  return v;
}
DI float fast_erf(float x) {
  const float ax = fabsf(x);
  const float t = __builtin_amdgcn_rcpf(1.f + 0.3275911f * ax);
  const float poly = t * (0.254829592f + t * (-0.284496736f + t * (1.421413741f + t * (-1.453152027f + t * 1.061405429f))));
  const float e = 1.f - poly * __builtin_amdgcn_exp2f(-1.4426950408889634f * ax * ax);
  return copysignf(e, x);
}

typedef unsigned u32x2_t __attribute__((ext_vector_type(2)));
DI int swap32_sum(int a, int b) {
  const u32x2_t r = __builtin_amdgcn_permlane32_swap((unsigned)a, (unsigned)b, false, false);
  return (int)(r[0] + r[1]);
}
DI int swap16_sum(int a, int b) {
  const u32x2_t r = __builtin_amdgcn_permlane16_swap((unsigned)a, (unsigned)b, false, false);
  return (int)(r[0] + r[1]);
}
template <int CTRL> DI int dpp_mov(int x) { return __builtin_amdgcn_update_dpp(x, x, CTRL, 0xF, 0xF, false); }
DI float swap32_max(float x) {
  const u32x2_t r = __builtin_amdgcn_permlane32_swap(__float_as_uint(x), __float_as_uint(x), false, false);
  return fmaxf(__uint_as_float(r[0]), __uint_as_float(r[1]));
}
DI float gelu_f(float v) { return 0.5f * v * (1.f + fast_erf(v * 0.70710678118654752f)); }
DI float sigmoid_f(float z) { return __builtin_amdgcn_rcpf(1.f + __builtin_amdgcn_exp2f(-1.4426950408889634f * z)); }
DI void rope_sincos(float ang, float& s, float& c) {
  double rev = (double)ang * 0.15915494309189535;
  rev -= rint(rev);
  float fr = (float)rev;
  s = __builtin_amdgcn_sinf(fr);
  c = __builtin_amdgcn_cosf(fr);
}

#define GS 72
DI void gemm_tile(const bf16_t* __restrict__ A, int lda, const bf16_t* __restrict__ B, int ldb, int K,
                  bf16_t* sm, f32x16 (&acc)[2][2]) {
  const int tid = TIDX(), lane = tid & 63, wave = tid >> 6;
  const int r = lane & 31, h = lane >> 5, wm = wave >> 1, wn = wave & 1;
  const int lrow = tid >> 3, lch = tid & 7;
  u32x4 ra0_0, ra0_1, ra0_2, ra0_3, rb0_0, rb0_1, rb0_2, rb0_3, ra1_0, ra1_1, ra1_2, ra1_3, rb1_0, rb1_1, rb1_2, rb1_3;
  const bf16_t* ag = A + (size_t)lrow * lda + lch * 8;
  const bf16_t* bg = B + (size_t)lrow * ldb + lch * 8;
  const int nk = K >> 6;
#define GLOAD1(RA, RB, KO, I)                                               \
    RA##_##I = *(const u32x4*)(ag + (size_t)(I) * 32 * lda + (KO));         \
    RB##_##I = *(const u32x4*)(bg + (size_t)(I) * 32 * ldb + (KO));
#define GLOAD(RA, RB, KO) { GLOAD1(RA, RB, KO, 0) GLOAD1(RA, RB, KO, 1) GLOAD1(RA, RB, KO, 2) GLOAD1(RA, RB, KO, 3) }
#define SSTORE1(RA, RB, BUF, I)                                             \
    *(u32x4*)(sa + (BUF) * 128 * GS + soff + (I) * 32 * GS) = RA##_##I;     \
    *(u32x4*)(sb + (BUF) * 128 * GS + soff + (I) * 32 * GS) = RB##_##I;
#define SSTORE(RA, RB, BUF) { SSTORE1(RA, RB, BUF, 0) SSTORE1(RA, RB, BUF, 1) SSTORE1(RA, RB, BUF, 2) SSTORE1(RA, RB, BUF, 3) }
#define COMPUTE(BUF)                                                        \
  {                                                                         \
    const bf16_t* ca = sa + (BUF) * 128 * GS + (wm * 64 + r) * GS + h * 8;  \
    const bf16_t* cb = sb + (BUF) * 128 * GS + (wn * 64 + r) * GS + h * 8;  \
    bf16x8 fa0[4], fa1[4], fb0[4], fb1[4];                                  \
    fa0[0] = *(const bf16x8*)(ca); fa1[0] = *(const bf16x8*)(ca + 32 * GS); \
    fb0[0] = *(const bf16x8*)(cb); fb1[0] = *(const bf16x8*)(cb + 32 * GS); \
    __builtin_amdgcn_sched_barrier(0);                                      \
    _Pragma("unroll") for (int ks = 0; ks < 4; ++ks) {                      \
      if (ks < 3) {                                                         \
        fa0[ks + 1] = *(const bf16x8*)(ca + (ks + 1) * 16); fa1[ks + 1] = *(const bf16x8*)(ca + 32 * GS + (ks + 1) * 16); \
        fb0[ks + 1] = *(const bf16x8*)(cb + (ks + 1) * 16); fb1[ks + 1] = *(const bf16x8*)(cb + 32 * GS + (ks + 1) * 16); \
      }                                                                     \
      c00 = MFMA(fa0[ks], fb0[ks], c00);                                    \
      c01 = MFMA(fa0[ks], fb1[ks], c01);                                    \
      c10 = MFMA(fa1[ks], fb0[ks], c10);                                    \
      c11 = MFMA(fa1[ks], fb1[ks], c11);                                    \
      __builtin_amdgcn_sched_barrier(0);                                    \
    }                                                                       \
  }
  bf16_t* sa = sm;
  bf16_t* sb = sm + 2 * 128 * GS;
  const int soff = lrow * GS + lch * 8;
  GLOAD(ra0, rb0, 0)
  GLOAD(ra1, rb1, 64)
  f32x16 c00, c01, c10, c11;
  {
    const f32x16 z = {0.f, 0.f, 0.f, 0.f, 0.f, 0.f, 0.f, 0.f, 0.f, 0.f, 0.f, 0.f, 0.f, 0.f, 0.f, 0.f};
    c00 = z; c01 = z; c10 = z; c11 = z;
  }
  SSTORE(ra0, rb0, 0)
  if (nk > 2) { GLOAD(ra0, rb0, 128) }
  __syncthreads();
  for (int kt = 0; kt < nk; kt += 2) {
    COMPUTE(0)
    SSTORE(ra1, rb1, 1)
    if (kt + 3 < nk) { GLOAD(ra1, rb1, (kt + 3) * 64) }
    __syncthreads();
    COMPUTE(1)
    if (kt + 2 < nk) {
      SSTORE(ra0, rb0, 0)
      if (kt + 4 < nk) { GLOAD(ra0, rb0, (kt + 4) * 64) }
    }
    __syncthreads();
  }
  acc[0][0] = c00; acc[0][1] = c01; acc[1][0] = c10; acc[1][1] = c11;
#undef GLOAD
#undef GLOAD1
#undef SSTORE1
#undef SSTORE
#undef COMPUTE
}

DI void lds_mma_128(const bf16_t* sa, const bf16_t* sb, f32x16 (&acc)[2][2]) {
  const int tid = TIDX(), lane = tid & 63, wave = tid >> 6;
  const int r = lane & 31, h = lane >> 5, wm = wave >> 1, wn = wave & 1;
  const bf16_t* ca = sa + (wm * 64 + r) * GS + h * 8;
  const bf16_t* cb = sb + (wn * 64 + r) * GS + h * 8;
#pragma unroll
  for (int ks = 0; ks < 4; ++ks) {
    const bf16x8 a0 = *(const bf16x8*)(ca + ks * 16), a1 = *(const bf16x8*)(ca + 32 * GS + ks * 16);
    const bf16x8 b0 = *(const bf16x8*)(cb + ks * 16), b1 = *(const bf16x8*)(cb + 32 * GS + ks * 16);
    acc[0][0] = MFMA(a0, b0, acc[0][0]);
    acc[0][1] = MFMA(a0, b1, acc[0][1]);
    acc[1][0] = MFMA(a1, b0, acc[1][0]);
    acc[1][1] = MFMA(a1, b1, acc[1][1]);
  }
}
#define EPI_BEGIN                                                              \
  {                                                                            \
    const int _lane = TIDX() & 63, _wave = TIDX() >> 6;              \
    const int _r = _lane & 31, _h = _lane >> 5, _wm = _wave >> 1, _wn = _wave & 1; \
    _Pragma("unroll") for (int _i = 0; _i < 2; ++_i)                           \
    _Pragma("unroll") for (int _j = 0; _j < 2; ++_j)                           \
    _Pragma("unroll") for (int _q = 0; _q < 16; ++_q) {                        \
      const int trow = _wm * 64 + _i * 32 + (_q & 3) + 8 * (_q >> 2) + 4 * _h; \
      const int tcol = _wn * 64 + _j * 32 + _r;                                \
      const float val = acc[_i][_j][_q];
#define EPI_END }}


DI bool xcd_item(int it, int NT, int& mt, int& nt) {
  const int G = gridDim.x;
  if ((G & 7) != 0) { if (it >= 128 * NT) return false; mt = it / NT; nt = it - mt * NT; return true; }
  const int S = G >> 3;
  const int rnd = it / G, b = it - rnd * G;
  const int xcd = b & 7, slot = b >> 3;
  const int li = rnd * S + slot;
  if (li >= 16 * NT) return false;
  const int ml = li / NT;
  mt = 16 * xcd + ml; nt = li - ml * NT;
  return true;
}

struct WS {
  half_t* X; bf16_t* H; char* scr; bf16_t* QP; int* PIDX; float* PG; float* MODS; float* KVMODS; float* SUMA; float* SUMH;
  bf16_t* W; unsigned char* TU; unsigned char* TV; float* SU; float* SV;
};
DI WS make_ws(char* ws) {
  WS w;
  w.X = (half_t*)(ws + OFF_X); w.H = (bf16_t*)(ws + OFF_H); w.scr = ws + OFF_SCR; w.QP = (bf16_t*)(ws + OFF_QP);
  w.PIDX = (int*)(ws + OFF_PIDX); w.PG = (float*)(ws + OFF_PG); w.MODS = (float*)(ws + OFF_MODS);
  w.KVMODS = w.MODS + 4 * 2 * 6144; w.SUMA = (float*)(ws + OFF_SUM); w.SUMH = w.SUMA + 2 * 128 * 1024;
  w.W = (bf16_t*)(ws + OFF_W); w.TU = (unsigned char*)(ws + OFF_TU); w.TV = (unsigned char*)(ws + OFF_TV); w.SU = (float*)(ws + OFF_SU); w.SV = (float*)(ws + OFF_SV);
  return w;
}

DI void convert_table_item(const Params& p, const WS& w, int gid) {
  const int lane = TIDX() & 63, wave = TIDX() >> 6;
  const int which = (gid >> 10) & 1;
  const int row0 = ((gid >> 11) * 1024 + (gid & 1023)) * 16 + wave * 4;
  const float* src = which ? p.peer_v : p.peer_u;
  unsigned char* dst = which ? w.TV : w.TU;
  float* sc = which ? w.SV : w.SU;
  float4 v[4][4];
#pragma unroll
  for (int u = 0; u < 4; ++u)
#pragma unroll
    for (int i = 0; i < 4; ++i) v[u][i] = *(const float4*)(src + (size_t)(row0 + u) * 1024 + i * 256 + lane * 4);
#pragma unroll
  for (int u = 0; u < 4; ++u) {
    const int row = row0 + u;
    float am = 0.f;
#pragma unroll
    for (int i = 0; i < 4; ++i)
      am = fmaxf(am, fmaxf(fmaxf(fabsf(v[u][i].x), fabsf(v[u][i].y)), fmaxf(fabsf(v[u][i].z), fabsf(v[u][i].w))));
#pragma unroll
    for (int o = 32; o > 0; o >>= 1) am = fmaxf(am, __shfl_xor(am, o));
    const float inv = am > 0.f ? 127.f / am : 0.f;
    const int bias = which ? 128 : 0;
#pragma unroll
    for (int i = 0; i < 4; ++i) {
      const int q0 = (int)rintf(v[u][i].x * inv) + bias, q1 = (int)rintf(v[u][i].y * inv) + bias;
      const int q2 = (int)rintf(v[u][i].z * inv) + bias, q3 = (int)rintf(v[u][i].w * inv) + bias;
      *(unsigned*)(dst + (size_t)row * 1024 + i * 256 + lane * 4) =
          (unsigned)(q0 & 255) | ((unsigned)(q1 & 255) << 8) | ((unsigned)(q2 & 255) << 16) | ((unsigned)(q3 & 255) << 24);
    }
    if (lane == 0) sc[row] = am * (1.f / 127.f);
  }
}

DI void phase_prep(const Params& p, const WS& w, char* smem) {
  const int tid = TIDX(), lane = tid & 63, wave = tid >> 6;
  TJob* sj = (TJob*)(smem + SMEM_MAIN);
  const int n_mods = 416, n_tconv = p.n_tconv, n_keys = 512, n_pad = 1, n_tab = 0;
  const int total = n_mods + n_tconv + n_keys + n_pad + n_tab;
  for (int it0 = blockIdx.x; it0 < total; it0 += gridDim.x) {
    int it = it0;
    if (it < n_mods) {
      float* sc = (float*)smem;
      float* red = sc + 2048;
      for (int i = tid; i < 2048; i += 256) { float v = p.c[i]; sc[i] = v / (1.f + __expf(-v)); }
      __syncthreads();
      const int gcol = it * 64 + lane;
      const float* Wp; int ld, l = 0, j;
      if (gcol < 24576) { l = gcol / 6144; j = gcol - l * 6144; Wp = p.ada_w + (size_t)l * 1024 * 6144 + j; ld = 6144; }
      else { j = gcol - 24576; Wp = p.kv_ada_w + j; ld = 2048; l = 4; }
      float a0 = 0.f, a1 = 0.f;
      const int k0 = wave * 256;
#pragma unroll 1
      for (int kb = 0; kb < 256; kb += 32) {
        float wv[32];
#pragma unroll
        for (int k = 0; k < 32; ++k) wv[k] = Wp[(size_t)(k0 + kb + k) * ld];
#pragma unroll
        for (int k = 0; k < 32; ++k) { a0 += sc[k0 + kb + k] * wv[k]; a1 += sc[1024 + k0 + kb + k] * wv[k]; }
      }
      red[(wave * 64 + lane) * 2] = a0; red[(wave * 64 + lane) * 2 + 1] = a1;
      __syncthreads();
      if (wave == 0) {
        float s0 = 0.f, s1 = 0.f;
#pragma unroll
        for (int q = 0; q < 4; ++q) { s0 += red[(q * 64 + lane) * 2]; s1 += red[(q * 64 + lane) * 2 + 1]; }
        if (l < 4) {
          float bb = p.ada_b[l * 6144 + j];
          w.MODS[(l * 2 + 0) * 6144 + j] = s0 + bb; w.MODS[(l * 2 + 1) * 6144 + j] = s1 + bb;
        } else {
          float bb = p.kv_ada_b[j];
          w.KVMODS[j] = s0 + bb; w.KVMODS[2048 + j] = s1 + bb;
        }
      }
      __syncthreads();
      continue;
    }
    it -= n_mods;
    if (it < n_tconv) {
      int jj = 0;
      for (int q = 0; q < NJOBS; ++q) if (it >= sj[q].tile0) jj = q;
      const TJob jb = sj[jj];
      float* tile = (float*)smem;
      const int tiles_n = (jb.N + 63) >> 6;
      const int lt = it - jb.tile0;
      const int tk = lt / tiles_n, tn = lt - tk * tiles_n;
      const int k0 = tk * 64, n0 = tn * 64;
      {
        const int nl = tid & 63, kl0 = tid >> 6;
        float tv[16];
#pragma unroll
        for (int i = 0; i < 16; ++i) {
          const int kl = kl0 + 4 * i;
          tv[i] = (n0 + nl < jb.N) ? jb.src[(size_t)(k0 + kl) * jb.N + n0 + nl] : 0.f;
        }
#pragma unroll
        for (int i = 0; i < 16; ++i) tile[(kl0 + 4 * i) * 65 + nl] = tv[i];
      }
      __syncthreads();
      {
        const int nl = tid >> 2, kq = tid & 3;
        if (n0 + nl < jb.N) {
          const int n = jb.rowbase + n0 + nl;
          const int drow = (jb.mode == 0) ? n : (64 * (n >> 5) + 32 * (jb.mode - 1) + (n & 31));
          unsigned pk[8];
#pragma unroll
          for (int e = 0; e < 8; ++e) pk[e] = pack2(tile[(kq * 16 + 2 * e) * 65 + nl], tile[(kq * 16 + 2 * e + 1) * 65 + nl]);
          uint4* dp = (uint4*)(jb.dst + (size_t)drow * jb.ldd + k0 + kq * 16);
          dp[0] = make_uint4(pk[0], pk[1], pk[2], pk[3]);
          dp[1] = make_uint4(pk[4], pk[5], pk[6], pk[7]);
        }
      }
      __syncthreads();
      continue;
    }
    it -= n_tconv;
    if (it < n_keys) {
      const size_t e = (size_t)it * 2048 + tid * 8;
      const float4 v0 = *(const float4*)(p.peer_keys + e), v1 = *(const float4*)(p.peer_keys + e + 4);
      *(uint4*)(w.W + W_KEYS + e) = make_uint4(pack2(v0.x, v0.y), pack2(v0.z, v0.w), pack2(v1.x, v1.y), pack2(v1.z, v1.w));
      continue;
    }
    it -= n_keys;
    if (it < n_pad) {
      uint4* dp = (uint4*)(w.W + W_DKV + 288 * 1024);
      for (int i = tid; i < 96 * 1024 / 8; i += 256) dp[i] = make_uint4(0, 0, 0, 0);
      continue;
    }
    it -= n_pad;
    convert_table_item(p, w, it);
  }
}

template <bool HALF_IN>
DI void phase_norm_rows(const void* __restrict__ Xv, const float* __restrict__ g, const float* __restrict__ shift0,
                        const float* __restrict__ scale0, int bstride, bf16_t* __restrict__ out) {
  const int lane = TIDX() & 63, wave = TIDX() >> 6;
  for (int it = blockIdx.x; it < T / 4; it += gridDim.x) {
    const int t = it * 4 + wave, b = t >> 13;
    float4 v[4]; float ss = 0.f;
#pragma unroll
    for (int i = 0; i < 4; ++i) {
      if (HALF_IN) {
        const uint2 hv = *(const uint2*)((const half_t*)Xv + (size_t)t * D + i * 256 + lane * 4);
        v[i] = make_float4(hlo(hv.x), hhi(hv.x), hlo(hv.y), hhi(hv.y));
      } else {
        v[i] = *(const float4*)((const float*)Xv + (size_t)t * D + i * 256 + lane * 4);
      }
      ss += v[i].x * v[i].x + v[i].y * v[i].y + v[i].z * v[i].z + v[i].w * v[i].w;
    }
    ss = wave_sum(ss);
    const float rinv = rsqrtf(ss * (1.f / 1024.f) + 1e-6f);
#pragma unroll
    for (int i = 0; i < 4; ++i) {
      const int col = i * 256 + lane * 4;
      const float4 gg = *(const float4*)(g + col);
      const float4 sc = *(const float4*)(scale0 + b * bstride + col);
      const float4 sh = *(const float4*)(shift0 + b * bstride + col);
      const float y0 = v[i].x * rinv * gg.x * (1.f + sc.x) + sh.x, y1 = v[i].y * rinv * gg.y * (1.f + sc.y) + sh.y;
      const float y2 = v[i].z * rinv * gg.z * (1.f + sc.z) + sh.z, y3 = v[i].w * rinv * gg.w * (1.f + sc.w) + sh.w;
      *(uint2*)(out + (size_t)t * D + col) = make_uint2(pack2(y0, y1), pack2(y2, y3));
    }
  }
}

DI void phase_win(const Params& p, const WS& w, int l, char* smem) {
  int bg = 0 + blockIdx.x;
  bf16_t* G = (bf16_t*)(w.scr + SA_G); bf16_t* REC = (bf16_t*)(w.scr + SA_REC);
  const bf16_t* Wt = w.W + W_WIN + (size_t)l * 2048 * 1024;
  for (int it = blockIdx.x; it < 128 * 16 + (int)gridDim.x; it += gridDim.x) {
    int mt, nt;
    if (!xcd_item(it, 16, mt, nt)) break;
    const int m0 = mt * 128, n0 = nt * 128;
    f32x16 acc[2][2];
    gemm_tile(w.H + (size_t)m0 * D, D, Wt + (size_t)n0 * D, D, D, (bf16_t*)smem, acc);
    if (n0 < 1024) {
      EPI_BEGIN G[(size_t)(m0 + trow) * D + n0 + tcol] = f2bf(gelu_f(val)); EPI_END
    } else {
      EPI_BEGIN REC[(size_t)(m0 + trow) * D + (n0 - 1024) + tcol] = f2bf(val); EPI_END
    }
    if (l == 0 && bg < 2048) { convert_table_item(p, w, bg); bg += gridDim.x; }
  }
  if (l == 0) for (; bg < 2048; bg += gridDim.x) convert_table_item(p, w, bg);
}
DI void phase_conv(const Params& p, const WS& w, int l) {
  const bf16_t* REC = (const bf16_t*)(w.scr + SA_REC); bf16_t* XC = (bf16_t*)(w.scr + SA_XC);
  const float* cw = p.lru_conv_w + l * 4 * 1024; const float* cb = p.lru_conv_b + l * 1024;
  for (int it = blockIdx.x; it < T * 128 / 256; it += gridDim.x) {
    const int gi = it * 256 + TIDX();
    const int t = gi >> 7, c0 = (gi & 127) * 8, s = t & (SEQ - 1);
    float a[8];
    {
      const float4 b0 = *(const float4*)(cb + c0), b1 = *(const float4*)(cb + c0 + 4);
      a[0] = b0.x; a[1] = b0.y; a[2] = b0.z; a[3] = b0.w; a[4] = b1.x; a[5] = b1.y; a[6] = b1.z; a[7] = b1.w;
    }
#pragma unroll
    for (int k = 0; k < 4; ++k) {
      const int ds = 3 - k;
      if (s - ds >= 0) {
        const uint4 rv = *(const uint4*)(REC + (size_t)(t - ds) * D + c0);
        const float4 w0 = *(const float4*)(cw + k * 1024 + c0), w1 = *(const float4*)(cw + k * 1024 + c0 + 4);
        a[0] += bflo(rv.x) * w0.x; a[1] += bfhi(rv.x) * w0.y; a[2] += bflo(rv.y) * w0.z; a[3] += bfhi(rv.y) * w0.w;
        a[4] += bflo(rv.z) * w1.x; a[5] += bfhi(rv.z) * w1.y; a[6] += bflo(rv.w) * w1.z; a[7] += bfhi(rv.w) * w1.w;
      }
    }
    *(uint4*)(XC + (size_t)t * D + c0) = make_uint4(pack2(a[0], a[1]), pack2(a[2], a[3]), pack2(a[4], a[5]), pack2(a[6], a[7]));
  }
}
DI void phase_gates(const Params& p, const WS& w, int l, char* smem) {
  int bg = 2048 + blockIdx.x;
  const bf16_t* XC = (const bf16_t*)(w.scr + SA_XC);
  bf16_t* AA = (bf16_t*)(w.scr + SA_AA); bf16_t* BB = (bf16_t*)(w.scr + SA_BB);
  const bf16_t* Wt = w.W + W_GATE + (size_t)l * 2048 * 256;
  const float* ba = p.lru_ba + l * 1024; const float* bx = p.lru_bx + l * 1024; const float* lam = p.lru_lambda + l * 1024;
  const int lane = TIDX() & 63, wave = TIDX() >> 6, r = lane & 31, h = lane >> 5, wm = wave >> 1, wn = wave & 1;
  for (int it = blockIdx.x; it < 128 * 16 + (int)gridDim.x; it += gridDim.x) {
    int mt, nt;
    if (!xcd_item(it, 16, mt, nt)) break;
    const int m0 = mt * 128, n0 = nt * 128;
    const int head = n0 >> 9;
    f32x16 acc[2][2];
    gemm_tile(XC + (size_t)m0 * D + head * 256, D, Wt + (size_t)n0 * 256, 256, 256, (bf16_t*)smem, acc);
    const int c = 32 * ((n0 >> 6) + wn) + r;
    const float bac = ba[c], bxc = bx[c];
    const float sp = log1pf(__expf(-lam[c]));
#pragma unroll
    for (int i = 0; i < 2; ++i)
#pragma unroll
      for (int q = 0; q < 16; ++q) {
        const int row = m0 + wm * 64 + i * 32 + (q & 3) + 8 * (q >> 2) + 4 * h;
        const float rg = sigmoid_f(acc[i][0][q] + bac), ig = sigmoid_f(acc[i][1][q] + bxc);
        const float la = -8.f * rg * sp;
        const float av = __builtin_amdgcn_exp2f(1.4426950408889634f * la);
        const float xc = bf2f(XC[(size_t)row * D + c]);
        const float bv = __builtin_amdgcn_sqrtf(fmaxf(1.f - av * av, 0.f)) * (ig * xc);
        const bf16_t omh = f2bf(1.f - av), bvh = f2bf(bv);
        AA[(size_t)row * D + c] = omh; BB[(size_t)row * D + c] = bvh;
        acc[i][0][q] = 1.f - bf2f(omh); acc[i][1][q] = bf2f(bvh);
      }
    {
      float sa[8], sh[8];
#pragma unroll
      for (int i = 0; i < 2; ++i)
#pragma unroll
        for (int g = 0; g < 4; ++g) {
          float hh = 0.f, ap = 1.f;
#pragma unroll
          for (int e = 0; e < 4; ++e) { const float a = acc[i][0][g * 4 + e], bb = acc[i][1][g * 4 + e]; hh = a * hh + bb; ap *= a; }
          sa[i * 4 + g] = ap; sh[i * 4 + g] = hh;
        }
      float HH = 0.f, AP = 1.f;
#pragma unroll
      for (int sgi = 0; sgi < 8; ++sgi) {
        const float pa = __shfl_xor(sa[sgi], 32), ph = __shfl_xor(sh[sgi], 32);
        HH = sa[sgi] * HH + sh[sgi]; AP *= sa[sgi];
        HH = pa * HH + ph; AP *= pa;
      }
      if (h == 0) {
        const int t0 = m0 + wm * 64;
        const int bb2 = t0 >> 13, chn = (t0 & (SEQ - 1)) >> 6;
        w.SUMA[(bb2 * 128 + chn) * 1024 + c] = AP; w.SUMH[(bb2 * 128 + chn) * 1024 + c] = HH;
      }
    }
    if (l == 0 && bg < 4096) { convert_table_item(p, w, bg); bg += gridDim.x; }
  }
  if (l == 0) for (; bg < 4096; bg += gridDim.x) convert_table_item(p, w, bg);
}
DI void phase_scan1(const WS& w) {
  const float* AA = (const float*)(w.scr + SA_AA); const float* BB = (const float*)(w.scr + SA_BB);
  for (int it = blockIdx.x; it < 1024; it += gridDim.x) {
    const int cg4 = it & 3, ch = (it >> 2) & 127, b = it >> 9;
    const int col = cg4 * 256 + TIDX();
    const size_t base = ((size_t)b * SEQ + ch * 64) * D + col;
    float hh = 0.f, ap = 1.f;
#pragma unroll 8
    for (int s = 0; s < 64; ++s) {
      const float a = AA[base + (size_t)s * D], bv = BB[base + (size_t)s * D];
      hh = a * hh + bv; ap *= a;
    }
    w.SUMA[(b * 128 + ch) * 1024 + col] = ap; w.SUMH[(b * 128 + ch) * 1024 + col] = hh;
  }
}
DI void phase_scan2(const WS& w) {
  const bf16_t* AA = (const bf16_t*)(w.scr + SA_AA); const bf16_t* BB = (const bf16_t*)(w.scr + SA_BB);
  const bf16_t* G = (const bf16_t*)(w.scr + SA_G); bf16_t* YG = (bf16_t*)(w.scr + SA_YG);
  for (int it = blockIdx.x; it < 1024; it += gridDim.x) {
    const int cg4 = it & 3, ch0 = (it >> 2) & 127, b = it >> 9;
    const int ch = b ? (127 - ch0) : ch0;
    const int col = cg4 * 256 + TIDX();
    float hh = 0.f;
    {
      const float* pa = w.SUMA + (size_t)b * 128 * 1024 + col; const float* ph = w.SUMH + (size_t)b * 128 * 1024 + col;
      int c2 = 0;
#pragma unroll 1
      for (; c2 + 16 <= ch; c2 += 16) {
        float sa[16], sh[16];
#pragma unroll
        for (int k = 0; k < 16; ++k) { sa[k] = pa[(c2 + k) * 1024]; sh[k] = ph[(c2 + k) * 1024]; }
#pragma unroll
        for (int k = 0; k < 16; ++k) hh = sa[k] * hh + sh[k];
      }
#pragma unroll 1
      for (; c2 < ch; ++c2) hh = pa[c2 * 1024] * hh + ph[c2 * 1024];
    }
    const size_t base = ((size_t)b * SEQ + ch * 64) * D + col;
#pragma unroll 1
    for (int s0 = 0; s0 < 64; s0 += 16) {
      bf16_t ra[16], rb[16], rg[16];
#pragma unroll
      for (int k = 0; k < 16; ++k) { ra[k] = AA[base + (size_t)(s0 + k) * D]; rb[k] = BB[base + (size_t)(s0 + k) * D]; rg[k] = G[base + (size_t)(s0 + k) * D]; }
#pragma unroll
      for (int k = 0; k < 16; ++k) {
        hh = (1.f - bf2f(ra[k])) * hh + bf2f(rb[k]);
        YG[base + (size_t)(s0 + k) * D] = f2bf(bf2f(rg[k]) * hh);
      }
    }
  }
}
DI void phase_outproj(const Params& p, const WS& w, int l, char* smem, bool dry) {
  int bg = 4096 + blockIdx.x;
  const bf16_t* A = (l < 2) ? (const bf16_t*)(w.scr + SA_YG) : (const bf16_t*)(w.scr + SB_AO);
  const bf16_t* Wt = (l < 2) ? (w.W + W_WOUT + (size_t)l * 1024 * 1024) : (w.W + W_WO + (size_t)(l - 2) * 1024 * 1024);
  for (int it = blockIdx.x; it < 128 * 8 + (int)gridDim.x; it += gridDim.x) {
    int mt, nt;
    if (!xcd_item(it, 8, mt, nt)) break;
    const int m0 = mt * 128, n0 = nt * 128;
    const float* g1 = w.MODS + (l * 2 + (m0 >> 13)) * 6144 + 2048;
    f32x16 acc[2][2];
    gemm_tile(A + (size_t)m0 * D, D, Wt + (size_t)n0 * D, D, D, (bf16_t*)smem, acc);
    EPI_BEGIN
      const size_t o = (size_t)(m0 + trow) * D + n0 + tcol;
      if (!dry) { const float xi = (l == 0) ? p.x[o] : (float)w.X[o]; w.X[o] = (half_t)(xi + g1[n0 + tcol] * val); }
    EPI_END
    if (l == 0 && !dry && bg < 6144) { convert_table_item(p, w, bg); bg += gridDim.x; }
  }
  if (l == 0 && !dry) for (; bg < 6144; bg += gridDim.x) convert_table_item(p, w, bg);
}
DI void phase_peerq(const WS& w, int l, char* smem) {
  const bf16_t* Wt = w.W + W_PQ + (size_t)l * 2048 * 1024;
  for (int it = blockIdx.x; it < 128 * 16; it += gridDim.x) {
    const int mt = it >> 4, nt = it & 15, m0 = mt * 128, n0 = nt * 128;
    f32x16 acc[2][2];
    gemm_tile(w.H + (size_t)m0 * D, D, Wt + (size_t)n0 * D, D, D, (bf16_t*)smem, acc);
    EPI_BEGIN w.QP[(size_t)(m0 + trow) * 2048 + n0 + tcol] = f2bf(val); EPI_END
  }
}
DI float key2f(int k) { unsigned b = (unsigned)(k ^ ((k >> 31) & 0x7fffffff)); return __uint_as_float(b & ~127u); }
DI int key2i(int k) { unsigned b = (unsigned)(k ^ ((k >> 31) & 0x7fffffff)); return (int)(b & 127u); }
DI void phase_topk(const Params& p, const WS& w, int l, char* smem) {
  int bg = 6144 + blockIdx.x;
  int* S = (int*)smem;
  const bf16_t* KB = w.W + W_KEYS + (size_t)l * 262144;
  const bf16_t* PQ = w.W + W_PQ + (size_t)l * 2048 * 1024;
  const int tid = TIDX();
  for (int it = blockIdx.x; it < 1024 + (int)gridDim.x; it += gridDim.x) {
    int mt, hd;
    if (!xcd_item(it, 8, mt, hd)) break;
    const int m0 = mt * 128;
    int L1[16];
#pragma unroll
    for (int q = 0; q < 16; ++q) L1[q] = 0;
#pragma unroll 1
    for (int pp = 0; pp < 2; ++pp) {
      {
        f32x16 acc[2][2];
        {
          f32x16 acc1[2][2];
          gemm_tile(w.H + (size_t)m0 * D, D, PQ + (size_t)(hd * 2 + pp) * 128 * D, D, D, (bf16_t*)smem, acc1);
          bf16_t* sa = (bf16_t*)smem; bf16_t* sb = sa + 2 * 128 * GS;
          {
            const int _lane = TIDX() & 63, _wave = TIDX() >> 6;
            const int _r = _lane & 31, _h = _lane >> 5, _wm = _wave >> 1, _wn = _wave & 1;
#pragma unroll
            for (int _i = 0; _i < 2; ++_i)
#pragma unroll
              for (int _j = 0; _j < 2; ++_j)
#pragma unroll
                for (int _q = 0; _q < 16; ++_q) {
                  const int trow = _wm * 64 + _i * 32 + (_q & 3) + 8 * (_q >> 2) + 4 * _h;
                  sa[_wn * 128 * GS + trow * GS + _j * 32 + _r] = f2bf(acc1[_i][_j][_q]);
                }
          }
          {
            const bf16_t* kg = KB + (size_t)(hd * 2 + pp) * 16384;
            const int krow = tid >> 3, kch = tid & 7;
#pragma unroll
            for (int i2 = 0; i2 < 4; ++i2) {
              const u32x4 k0 = *(const u32x4*)(kg + (krow + 32 * i2) * 128 + kch * 8);
              const u32x4 k1 = *(const u32x4*)(kg + (krow + 32 * i2) * 128 + 64 + kch * 8);
              *(u32x4*)(sb + (krow + 32 * i2) * GS + kch * 8) = k0;
              *(u32x4*)(sb + 128 * GS + (krow + 32 * i2) * GS + kch * 8) = k1;
            }
          }
          __syncthreads();
          {
            const f32x16 z = {0.f, 0.f, 0.f, 0.f, 0.f, 0.f, 0.f, 0.f, 0.f, 0.f, 0.f, 0.f, 0.f, 0.f, 0.f, 0.f};
            acc[0][0] = z; acc[0][1] = z; acc[1][0] = z; acc[1][1] = z;
          }
          lds_mma_128(sa, sb, acc);
          lds_mma_128(sa + 128 * GS, sb + 128 * GS, acc);
          __syncthreads();
        }
        EPI_BEGIN
          const unsigned bits = (__float_as_uint(val) & ~127u) | (unsigned)tcol;
          const int key = (int)bits ^ (((int)bits >> 31) & 0x7fffffff);
          S[trow * 128 + (tcol ^ (trow & 31))] = key;
        EPI_END
      }
      __syncthreads();
      const int row = tid & 127, half = tid >> 7;
      int top[16];
      {
        int e[64];
#pragma unroll
        for (int c = 0; c < 64; ++c) e[c] = S[row * 128 + half * 64 + (c ^ (row & 31))];
#pragma unroll
        for (int gb = 0; gb < 64; gb += 16) {
#pragma unroll
          for (int k = 2; k <= 16; k <<= 1) {
#pragma unroll
            for (int j = k >> 1; j > 0; j >>= 1) {
#pragma unroll
              for (int i = 0; i < 16; ++i) {
                const int l2 = i ^ j;
                if (l2 > i) {
                  const bool desc = ((i & k) == 0);
                  const int a = e[gb + i], b = e[gb + l2];
                  const int hi = max(a, b), lo = min(a, b);
                  e[gb + i] = desc ? hi : lo; e[gb + l2] = desc ? lo : hi;
                }
              }
            }
          }
        }
#pragma unroll
        for (int step = 0; step < 3; ++step) {
          const int ga = (step == 1) ? 32 : 0, gbb = (step == 0) ? 16 : ((step == 1) ? 48 : 32);
#pragma unroll
          for (int i = 0; i < 16; ++i) e[ga + i] = max(e[ga + i], e[gbb + 15 - i]);
#pragma unroll
          for (int j = 8; j > 0; j >>= 1) {
#pragma unroll
            for (int i = 0; i < 16; ++i) {
              const int l2 = i ^ j;
              if (l2 > i) {
                const int a = e[ga + i], b = e[ga + l2];
                e[ga + i] = max(a, b); e[ga + l2] = min(a, b);
              }
            }
          }
        }
#pragma unroll
        for (int tt = 0; tt < 16; ++tt) top[tt] = e[tt];
      }
      __syncthreads();
#pragma unroll
      for (int tt = 0; tt < 16; ++tt) S[(row * 2 + half) * 16 + tt] = top[tt];
      __syncthreads();
      if (tid < 128) {
        int m[16]; int pa = 0, pb = 0;
#pragma unroll
        for (int tt = 0; tt < 16; ++tt) {
          const int a = S[(tid * 2) * 16 + pa], b = S[(tid * 2 + 1) * 16 + pb];
          if (a > b) { m[tt] = a; ++pa; } else { m[tt] = b; ++pb; }
        }
        if (pp == 0) {
#pragma unroll
          for (int q = 0; q < 16; ++q) L1[q] = m[q];
        } else {
          int* S2 = S + 4096 + tid * 16;
#pragma unroll
          for (int q = 0; q < 16; ++q) S2[q] = m[q];
          unsigned long long P = 0ull;
          float cv[16]; int ce[16];
#pragma unroll
          for (int tt = 0; tt < 16; ++tt) {
            float best = -3.0e38f; int besta = 0, beste = 0;
#pragma unroll
            for (int a = 0; a <= tt; ++a) {
              const int pa2 = (int)((P >> (4 * a)) & 15ull);
              const int k2 = S2[pa2];
              const float cand = key2f(L1[a]) + key2f(k2);
              if (cand > best) { best = cand; besta = a; beste = key2i(L1[a]) * 128 + key2i(k2); }
            }
            cv[tt] = best; ce[tt] = beste;
            P += 1ull << (4 * besta);
          }
          float sum = 0.f;
          const float cmax = cv[0];
#pragma unroll
          for (int q = 0; q < 16; ++q) { cv[q] = __expf(cv[q] - cmax); sum += cv[q]; }
          const float inv = 1.f / sum;
          int* ip = w.PIDX + ((size_t)(m0 + tid) * 8 + hd) * 16;
          float* gp = w.PG + ((size_t)(m0 + tid) * 8 + hd) * 16;
#pragma unroll
          for (int q = 0; q < 4; ++q) {
            *(int4*)(ip + q * 4) = make_int4(ce[q * 4], ce[q * 4 + 1], ce[q * 4 + 2], ce[q * 4 + 3]);
            *(float4*)(gp + q * 4) = make_float4(cv[q * 4] * inv, cv[q * 4 + 1] * inv, cv[q * 4 + 2] * inv, cv[q * 4 + 3] * inv);
          }
        }
      }
      __syncthreads();
    }
    if (l == 0 && bg < 8192) { convert_table_item(p, w, bg); bg += gridDim.x; }
  }
  if (l == 0) for (; bg < 8192; bg += gridDim.x) convert_table_item(p, w, bg);
}
DI void phase_exp(const Params& p, const WS& w, int l, bool dry) {
  const unsigned char* TU = w.TU + (size_t)l * 16384 * 1024; const unsigned char* TV = w.TV + (size_t)l * 16384 * 1024;
  const float* SU = w.SU + l * 16384; const float* SV = w.SV + l * 16384;
  const int lane = TIDX() & 63, wave = TIDX() >> 6;
  const bool hi5 = (lane & 32) != 0, hi4 = (lane & 16) != 0, hi3 = (lane & 8) != 0;
  const int esel = (lane >> 3) & 7;
  for (int it = blockIdx.x; it < T / 4; it += gridDim.x) {
    const int t = __builtin_amdgcn_readfirstlane(it * 4 + wave);
    const int b = t >> 13;
    int hq[4]; float hs;
    {
      const u32x4* hp = (const u32x4*)(w.H + (size_t)t * D + lane * 16);
      const u32x4 ha = hp[0], hb = hp[1];
      float hv[16];
      hv[0] = bflo(ha.x); hv[1] = bfhi(ha.x); hv[2] = bflo(ha.y); hv[3] = bfhi(ha.y); hv[4] = bflo(ha.z); hv[5] = bfhi(ha.z); hv[6] = bflo(ha.w); hv[7] = bfhi(ha.w);
      hv[8] = bflo(hb.x); hv[9] = bfhi(hb.x); hv[10] = bflo(hb.y); hv[11] = bfhi(hb.y); hv[12] = bflo(hb.z); hv[13] = bfhi(hb.z); hv[14] = bflo(hb.w); hv[15] = bfhi(hb.w);
      float am = 0.f;
#pragma unroll
      for (int q = 0; q < 16; ++q) am = fmaxf(am, fabsf(hv[q]));
#pragma unroll
      for (int o = 32; o > 0; o >>= 1) am = fmaxf(am, __shfl_xor(am, o));
      const float inv = am > 0.f ? 127.f / am : 0.f;
      hs = am * (1.f / 127.f);
#pragma unroll
      for (int q = 0; q < 4; ++q) {
        const int q0 = (int)rintf(hv[q * 4] * inv), q1 = (int)rintf(hv[q * 4 + 1] * inv), q2 = (int)rintf(hv[q * 4 + 2] * inv), q3 = (int)rintf(hv[q * 4 + 3] * inv);
        hq[q] = (int)((unsigned)(q0 & 255) | ((unsigned)(q1 & 255) << 8) | ((unsigned)(q2 & 255) << 16) | ((unsigned)(q3 & 255) << 24));
      }
    }
    const int* ip = w.PIDX + (size_t)t * 128; const float* gp = w.PG + (size_t)t * 128;
    const int mi0 = ip[lane], mi1 = ip[64 + lane]; const float mg0 = gp[lane], mg1 = gp[64 + lane];
    float out[16];
#pragma unroll
    for (int q = 0; q < 16; ++q) out[q] = 0.f;
    float csum = 0.f;
#define EXP_LOAD(P, E0)                                                       \
    {                                                                         \
      const int _mi = ((E0) < 64) ? mi0 : mi1; const float _mg = ((E0) < 64) ? mg0 : mg1; \
      const int _eb = (E0) & 63;                                              \
      _Pragma("unroll") for (int q = 0; q < 8; ++q) {                         \
        const int _id = __builtin_amdgcn_readlane(_mi, _eb + q);              \
        uu##P[q] = *(const u32x4*)(TU + (size_t)_id * 1024 + lane * 16);      \
        vv##P[q] = *(const u32x4*)(TV + (size_t)_id * 1024 + lane * 16);      \
        sv##P[q] = SV[_id];                                                   \
      }                                                                       \
      const int _idsel = __shfl(_mi, _eb + esel);                             \
      gs##P = __shfl(_mg, _eb + esel);                                        \
      su##P = SU[_idsel];                                                     \
    }
#define EXP_COMPUTE(P)                                                        \
    {                                                                         \
      int d[8];                                                               \
      _Pragma("unroll") for (int q = 0; q < 8; ++q) {                         \
        int a0 = __builtin_amdgcn_sdot4((int)uu##P[q].x, hq[0], 0, false);    \
        int a1 = __builtin_amdgcn_sdot4((int)uu##P[q].y, hq[1], 0, false);    \
        a0 = __builtin_amdgcn_sdot4((int)uu##P[q].z, hq[2], a0, false);       \
        a1 = __builtin_amdgcn_sdot4((int)uu##P[q].w, hq[3], a1, false);       \
        d[q] = a0 + a1;                                                       \
      }                                                                       \
      int k4[4];                                                              \
      _Pragma("unroll") for (int q = 0; q < 4; ++q) k4[q] = swap32_sum(d[q], d[4 + q]); \
      int m2[2];                                                              \
      _Pragma("unroll") for (int q = 0; q < 2; ++q) m2[q] = swap16_sum(k4[q], k4[2 + q]); \
      int n1 = (hi3 ? m2[1] : m2[0]) + dpp_mov<0x140>(hi3 ? m2[0] : m2[1]);   \
      n1 += dpp_mov<0xB1>(n1); n1 += dpp_mov<0x4E>(n1); n1 += dpp_mov<0x141>(n1); \
      const float act = (float)n1 * (su##P * hs);                             \
      const float wv = gs##P * gelu_f(act);                                   \
      const int wvi = __builtin_bit_cast(int, wv);                            \
      _Pragma("unroll") for (int q = 0; q < 8; ++q) {                         \
        const float cq = __builtin_bit_cast(float, __builtin_amdgcn_readlane(wvi, 8 * q)) * sv##P[q]; \
        csum += cq;                                                           \
        const unsigned x0 = vv##P[q].x, x1 = vv##P[q].y, x2 = vv##P[q].z, x3 = vv##P[q].w; \
        out[0] += cq * (float)(x0 & 255u); out[1] += cq * (float)((x0 >> 8) & 255u); out[2] += cq * (float)((x0 >> 16) & 255u); out[3] += cq * (float)(x0 >> 24); \
        out[4] += cq * (float)(x1 & 255u); out[5] += cq * (float)((x1 >> 8) & 255u); out[6] += cq * (float)((x1 >> 16) & 255u); out[7] += cq * (float)(x1 >> 24); \
        out[8] += cq * (float)(x2 & 255u); out[9] += cq * (float)((x2 >> 8) & 255u); out[10] += cq * (float)((x2 >> 16) & 255u); out[11] += cq * (float)(x2 >> 24); \
        out[12] += cq * (float)(x3 & 255u); out[13] += cq * (float)((x3 >> 8) & 255u); out[14] += cq * (float)((x3 >> 16) & 255u); out[15] += cq * (float)(x3 >> 24); \
      }                                                                       \
    }
    u32x4 uuA[8], vvA[8], uuB[8], vvB[8]; float svA[8], svB[8]; float gsA, gsB, suA, suB;
    EXP_LOAD(A, 0)
#pragma unroll 1
    for (int e0 = 0; e0 < 128; e0 += 16) {
      EXP_LOAD(B, e0 + 8)
      EXP_COMPUTE(A)
      { const int en = (e0 + 16 < 128) ? (e0 + 16) : 120; EXP_LOAD(A, en) }
      EXP_COMPUTE(B)
    }
#undef EXP_LOAD
#undef EXP_COMPUTE
    if (dry) continue;
    const float* g2 = w.MODS + (l * 2 + b) * 6144 + 5120;
    const int c0 = lane * 16;
    float xn[16]; float ss = 0.f;
#pragma unroll
    for (int i = 0; i < 4; ++i) {
      const uint2 xh = *(const uint2*)(w.X + (size_t)t * D + c0 + i * 4);
      const float4 x0 = make_float4(hlo(xh.x), hhi(xh.x), hlo(xh.y), hhi(xh.y));
      const float4 ga = *(const float4*)(g2 + c0 + i * 4);
      xn[i * 4 + 0] = x0.x + ga.x * (out[i * 4 + 0] - 128.f * csum); xn[i * 4 + 1] = x0.y + ga.y * (out[i * 4 + 1] - 128.f * csum);
      xn[i * 4 + 2] = x0.z + ga.z * (out[i * 4 + 2] - 128.f * csum); xn[i * 4 + 3] = x0.w + ga.w * (out[i * 4 + 3] - 128.f * csum);
    }
#pragma unroll
    for (int q = 0; q < 16; ++q) ss += xn[q] * xn[q];
    ss = wave_sum(ss);
    const float rinv = rsqrtf(ss * (1.f / 1024.f) + 1e-6f);
    if (l == 3) {
#pragma unroll
      for (int i = 0; i < 4; ++i) {
        const float4 ga = *(const float4*)(p.final_g + c0 + i * 4);
        *(float4*)(p.out + (size_t)t * D + c0 + i * 4) = make_float4(xn[i * 4] * rinv * ga.x, xn[i * 4 + 1] * rinv * ga.y, xn[i * 4 + 2] * rinv * ga.z, xn[i * 4 + 3] * rinv * ga.w);
      }
    } else {
      const float* ng = p.norm_mix_g + (l + 1) * 1024;
      const float* nsh = w.MODS + ((l + 1) * 2 + b) * 6144;
      const float* nsc = nsh + 1024;
      float y[16];
#pragma unroll
      for (int i = 0; i < 4; ++i) {
        *(uint2*)(w.X + (size_t)t * D + c0 + i * 4) = make_uint2(packh2(xn[i * 4], xn[i * 4 + 1]), packh2(xn[i * 4 + 2], xn[i * 4 + 3]));
        const float4 ga = *(const float4*)(ng + c0 + i * 4), sc = *(const float4*)(nsc + c0 + i * 4), sh = *(const float4*)(nsh + c0 + i * 4);
        y[i * 4 + 0] = xn[i * 4 + 0] * rinv * ga.x * (1.f + sc.x) + sh.x; y[i * 4 + 1] = xn[i * 4 + 1] * rinv * ga.y * (1.f + sc.y) + sh.y;
        y[i * 4 + 2] = xn[i * 4 + 2] * rinv * ga.z * (1.f + sc.z) + sh.z; y[i * 4 + 3] = xn[i * 4 + 3] * rinv * ga.w * (1.f + sc.w) + sh.w;
      }
      u32x4 o0, o1;
      o0.x = pack2(y[0], y[1]); o0.y = pack2(y[2], y[3]); o0.z = pack2(y[4], y[5]); o0.w = pack2(y[6], y[7]);
      o1.x = pack2(y[8], y[9]); o1.y = pack2(y[10], y[11]); o1.z = pack2(y[12], y[13]); o1.w = pack2(y[14], y[15]);
      *(u32x4*)(w.H + (size_t)t * D + c0) = o0; *(u32x4*)(w.H + (size_t)t * D + c0 + 8) = o1;
      if (l == 1) {
        bf16_t* HKV = (bf16_t*)(w.scr + SB_HKV);
        const float* ksh = w.KVMODS + b * 2048; const float* ksc = ksh + 1024;
#pragma unroll
        for (int i = 0; i < 4; ++i) {
          const float4 ga = *(const float4*)(p.kv_norm_g + c0 + i * 4), sc = *(const float4*)(ksc + c0 + i * 4), sh = *(const float4*)(ksh + c0 + i * 4);
          y[i * 4 + 0] = xn[i * 4 + 0] * rinv * ga.x * (1.f + sc.x) + sh.x; y[i * 4 + 1] = xn[i * 4 + 1] * rinv * ga.y * (1.f + sc.y) + sh.y;
          y[i * 4 + 2] = xn[i * 4 + 2] * rinv * ga.z * (1.f + sc.z) + sh.z; y[i * 4 + 3] = xn[i * 4 + 3] * rinv * ga.w * (1.f + sc.w) + sh.w;
        }
        o0.x = pack2(y[0], y[1]); o0.y = pack2(y[2], y[3]); o0.z = pack2(y[4], y[5]); o0.w = pack2(y[6], y[7]);
        o1.x = pack2(y[8], y[9]); o1.y = pack2(y[10], y[11]); o1.z = pack2(y[12], y[13]); o1.w = pack2(y[14], y[15]);
        *(u32x4*)(HKV + (size_t)t * D + c0) = o0; *(u32x4*)(HKV + (size_t)t * D + c0 + 8) = o1;
      }
    }
  }
}
DI void phase_down(const WS& w, int l, char* smem) {
  float* KVRAW = (float*)(w.scr + SB_KVRAW); float* QLRAW = (float*)(w.scr + SB_QLRAW);
  const bf16_t* HKV = (const bf16_t*)(w.scr + SB_HKV);
  for (int pass = (l == 2) ? 0 : 1; pass < 2; ++pass) {
    const bool kv = (pass == 0);
    const bf16_t* A = kv ? HKV : w.H;
    const bf16_t* Wt = kv ? (w.W + W_DKV) : (w.W + W_DQ + (size_t)(l - 2) * 384 * 1024);
    float* O = kv ? KVRAW : QLRAW;
    for (int it = blockIdx.x; it < 384 + (int)gridDim.x; it += gridDim.x) {
      int mt, nt;
      if (!xcd_item(it, 3, mt, nt)) break;
      const int m0 = mt * 128, n0 = nt * 128;
      f32x16 acc[2][2];
      gemm_tile(A + (size_t)m0 * D, D, Wt + (size_t)n0 * D, D, D, (bf16_t*)smem, acc);
      EPI_BEGIN O[(size_t)(m0 + trow) * 384 + n0 + tcol] = val; EPI_END
    }
  }
}
DI void phase_lnorm(const Params& p, const WS& w, int l) {
  const int lane = TIDX() & 63, wave = TIDX() >> 6;
  const int nkv = (l == 2) ? T / 4 : 0;
  const float* KVRAW = (const float*)(w.scr + SB_KVRAW); const float* QLRAW = (const float*)(w.scr + SB_QLRAW);
  bf16_t* CKV = (bf16_t*)(w.scr + SB_CKV); bf16_t* KR = (bf16_t*)(w.scr + SB_KR); bf16_t* QL = (bf16_t*)(w.scr + SB_QL);
  for (int it0 = blockIdx.x; it0 < nkv + T / 4; it0 += gridDim.x) {
    if (it0 < nkv) {
      const int t = it0 * 4 + wave;
      const float* rr = KVRAW + (size_t)t * 384;
      const float4 v = *(const float4*)(rr + lane * 4);
      float ss = wave_sum(v.x * v.x + v.y * v.y + v.z * v.z + v.w * v.w);
      const float rinv = rsqrtf(ss * (1.f / 256.f) + 1e-6f);
      const float4 gg = *(const float4*)(p.kv_latent_g + lane * 4);
      *(uint2*)(CKV + (size_t)t * 256 + lane * 4) = make_uint2(pack2(v.x * rinv * gg.x, v.y * rinv * gg.y), pack2(v.z * rinv * gg.z, v.w * rinv * gg.w));
      if (lane < 16) {
        const float x1 = rr[256 + lane], x2 = rr[272 + lane];
        const float ang = (float)p.pos[t] * ROPE_FREQ[lane];
        float sn, cs; rope_sincos(ang, sn, cs);
        KR[(size_t)t * 32 + lane] = f2bf(x1 * cs - x2 * sn);
        KR[(size_t)t * 32 + 16 + lane] = f2bf(x1 * sn + x2 * cs);
      }
    } else {
      const int t = (it0 - nkv) * 4 + wave;
      const float* rr = QLRAW + (size_t)t * 384;
      float2 v[3]; float ss = 0.f;
#pragma unroll
      for (int i = 0; i < 3; ++i) { v[i] = *(const float2*)(rr + i * 128 + lane * 2); ss += v[i].x * v[i].x + v[i].y * v[i].y; }
      ss = wave_sum(ss);
      const float rinv = rsqrtf(ss * (1.f / 384.f) + 1e-6f);
      const float* gq = p.q_latent_g + (l - 2) * 384;
#pragma unroll
      for (int i = 0; i < 3; ++i) {
        const int col = i * 128 + lane * 2;
        *(unsigned*)(QL + (size_t)t * 384 + col) = pack2(v[i].x * rinv * gq[col], v[i].y * rinv * gq[col + 1]);
      }
    }
  }
}
DI void phase_up(const WS& w, int l, char* smem) {
  const bf16_t* CKV = (const bf16_t*)(w.scr + SB_CKV); const bf16_t* QL = (const bf16_t*)(w.scr + SB_QL);
  bf16_t* KN = (bf16_t*)(w.scr + SB_KN); bf16_t* VT = (bf16_t*)(w.scr + SB_VT); bf16_t* QM = (bf16_t*)(w.scr + SB_QM);
  const bf16_t* UKV = w.W + W_UKV; const bf16_t* UQ = w.W + W_UQ + (size_t)(l - 2) * 1536 * 384;
  if (l == 2) {
    for (int it = blockIdx.x; it < 2048 + (int)gridDim.x; it += gridDim.x) {
      int mt, nt16;
      if (!xcd_item(it, 16, mt, nt16)) break;
      const int m0 = mt * 128, n0 = (nt16 & 7) * 128;
      f32x16 acc[2][2];
      if (nt16 < 8) {
        gemm_tile(CKV + (size_t)m0 * 256, 256, UKV + (size_t)n0 * 256, 256, 256, (bf16_t*)smem, acc);
        EPI_BEGIN KN[(size_t)(m0 + trow) * D + n0 + tcol] = f2bf(val); EPI_END
      } else {
        gemm_tile(UKV + (size_t)(1024 + n0) * 256, 256, CKV + (size_t)m0 * 256, 256, 256, (bf16_t*)smem, acc);
        const int b = m0 >> 13, s0 = m0 & (SEQ - 1);
        EPI_BEGIN VT[((size_t)b * 1024 + n0 + trow) * SEQ + s0 + tcol] = f2bf(val); EPI_END
      }
    }
  }
  for (int it = blockIdx.x; it < 1536 + (int)gridDim.x; it += gridDim.x) {
    int mt, nt;
    if (!xcd_item(it, 12, mt, nt)) break;
    const int m0 = mt * 128, n0 = nt * 128;
    f32x16 acc[2][2];
    gemm_tile(QL + (size_t)m0 * 384, 384, UQ + (size_t)n0 * 384, 384, 384, (bf16_t*)smem, acc);
    EPI_BEGIN QM[(size_t)(m0 + trow) * 1536 + n0 + tcol] = f2bf(val); EPI_END
  }
}
#define KS_ 104
#define VS_ 72
DI void phase_attn(const Params& p, const WS& w, char* smem) {
  bf16_t* sK = (bf16_t*)smem;
  bf16_t* sV = sK + 2 * 64 * KS_;
  const bf16_t* KN = (const bf16_t*)(w.scr + SB_KN); const bf16_t* VT = (const bf16_t*)(w.scr + SB_VT);
  const bf16_t* KR = (const bf16_t*)(w.scr + SB_KR); const bf16_t* QM = (const bf16_t*)(w.scr + SB_QM);
  bf16_t* AO = (bf16_t*)(w.scr + SB_AO);
  const int tid = TIDX(), lane = tid & 63, wave = tid >> 6, r = lane & 31, h = lane >> 5;
  const int pr = (r & 19) | ((r & 4) << 1) | ((r & 8) >> 1);
  const int G = gridDim.x;
  const float QSC = 0.10206207261596575f * 1.4426950408889634f;
  for (int idx = blockIdx.x; idx < 2048; idx += G) {
    const int rnd = idx / G, jj = idx - rnd * G;
    int qt, bh;
    if (G == 512) {
      const int xcd = jj & 7, slot = jj >> 3;
      bh = xcd + 8 * rnd;
      qt = (rnd & 1) ? slot : (63 - slot);
    } else {
      const int spos = ((rnd & 1) && ((rnd + 1) * G <= 2048)) ? (rnd * G + (G - 1 - jj)) : idx;
      qt = 63 - (spos >> 5); bh = spos & 31;
    }
    const int b = bh >> 4, hd = bh & 15;
    const int q0 = qt * 128, tok0 = b * SEQ;
    const int qrow = tok0 + q0 + wave * 32 + r;
    const int qposi = p.pos[qrow];
    bf16x8 qf[6];
    {
      const bf16_t* qp = QM + (size_t)qrow * 1536 + hd * 96 + h * 8;
      uint4 qr[6];
#pragma unroll
      for (int ks = 0; ks < 6; ++ks) qr[ks] = *(const uint4*)(qp + ks * 16);
#pragma unroll
      for (int ks = 0; ks < 4; ++ks) {
        uint4 o;
        o.x = pack2(bflo(qr[ks].x) * QSC, bfhi(qr[ks].x) * QSC); o.y = pack2(bflo(qr[ks].y) * QSC, bfhi(qr[ks].y) * QSC);
        o.z = pack2(bflo(qr[ks].z) * QSC, bfhi(qr[ks].z) * QSC); o.w = pack2(bflo(qr[ks].w) * QSC, bfhi(qr[ks].w) * QSC);
        qf[ks] = __builtin_bit_cast(bf16x8, o);
      }
      float x1[8], x2[8], o1[8], o2[8];
      x1[0] = bflo(qr[4].x); x1[1] = bfhi(qr[4].x); x1[2] = bflo(qr[4].y); x1[3] = bfhi(qr[4].y);
      x1[4] = bflo(qr[4].z); x1[5] = bfhi(qr[4].z); x1[6] = bflo(qr[4].w); x1[7] = bfhi(qr[4].w);
      x2[0] = bflo(qr[5].x); x2[1] = bfhi(qr[5].x); x2[2] = bflo(qr[5].y); x2[3] = bfhi(qr[5].y);
      x2[4] = bflo(qr[5].z); x2[5] = bfhi(qr[5].z); x2[6] = bflo(qr[5].w); x2[7] = bfhi(qr[5].w);
      const float fpos = (float)qposi;
#pragma unroll
      for (int j = 0; j < 8; ++j) {
        const float ang = fpos * ROPE_FREQ[h * 8 + j];
        float sn, cs; rope_sincos(ang, sn, cs);
        o1[j] = (x1[j] * cs - x2[j] * sn) * QSC; o2[j] = (x1[j] * sn + x2[j] * cs) * QSC;
      }
      uint4 o;
      o.x = pack2(o1[0], o1[1]); o.y = pack2(o1[2], o1[3]); o.z = pack2(o1[4], o1[5]); o.w = pack2(o1[6], o1[7]);
      qf[4] = __builtin_bit_cast(bf16x8, o);
      o.x = pack2(o2[0], o2[1]); o.y = pack2(o2[2], o2[3]); o.z = pack2(o2[4], o2[5]); o.w = pack2(o2[6], o2[7]);
      qf[5] = __builtin_bit_cast(bf16x8, o);
    }
    const int nt = 2 * (qt + 1);
    const int kkey = tid >> 3, kch = tid & 7;
    const int rkey = tid >> 2, rch = tid & 3;
    const bf16_t* gKN = KN + (size_t)(tok0 + kkey) * D + hd * 64 + kch * 8;
    const bf16_t* gKR = KR + (size_t)(tok0 + rkey) * 32 + rch * 8;
    const bf16_t* gVT = VT + ((size_t)bh * 64 + kkey) * SEQ + kch * 8;
    bf16_t* sVV = sK + 2 * 64 * KS_;
    u32x4 Gk0, Gk1, Gr, Gv0, Gv1;
#define ALOAD(KT)                                                            \
    {                                                                        \
      const size_t k1 = (size_t)(KT) * 64;                                   \
      Gk0 = *(const u32x4*)(gKN + k1 * D); Gk1 = *(const u32x4*)(gKN + (k1 + 32) * D); \
      Gr = *(const u32x4*)(gKR + k1 * 32);                                   \
      Gv0 = *(const u32x4*)(gVT + k1); Gv1 = *(const u32x4*)(gVT + (size_t)32 * SEQ + k1); \
    }
#define ASTORE(KB, VB)                                                       \
    {                                                                        \
      bf16_t* nK = sK + (KB) * 64 * KS_; bf16_t* nV = sVV + (VB) * 64 * VS_; \
      *(u32x4*)(nK + kkey * KS_ + kch * 8) = Gk0; *(u32x4*)(nK + (kkey + 32) * KS_ + kch * 8) = Gk1; \
      *(u32x4*)(nK + rkey * KS_ + 64 + rch * 8) = Gr;                        \
      *(u32x4*)(nV + kkey * VS_ + kch * 8) = Gv0; *(u32x4*)(nV + (kkey + 32) * VS_ + kch * 8) = Gv1; \
    }
#define QK_TILE(ST, KB, KT)                                                  \
    {                                                                        \
      const bf16_t* cK = sK + (KB) * 64 * KS_;                               \
      _Pragma("unroll") for (int q = 0; q < 16; ++q) { ST[0][q] = 0.f; ST[1][q] = 0.f; } \
      _Pragma("unroll") for (int kb = 0; kb < 2; ++kb)                       \
      _Pragma("unroll") for (int ks = 0; ks < 6; ++ks) {                     \
        const bf16x8 a = *(const bf16x8*)(cK + (32 * kb + pr) * KS_ + ks * 16 + h * 8); \
        ST[kb] = MFMA(a, qf[ks], ST[kb]);                                    \
      }                                                                      \
      if ((KT) >= nt - 2) {                                                  \
        const int kbase = tok0 + (KT) * 64 + 8 * h;                          \
        _Pragma("unroll") for (int kb = 0; kb < 2; ++kb)                     \
        _Pragma("unroll") for (int g2 = 0; g2 < 2; ++g2) {                   \
          const int4 pa = *(const int4*)(p.pos + kbase + 32 * kb + 16 * g2), pb = *(const int4*)(p.pos + kbase + 32 * kb + 16 * g2 + 4); \
          if (pa.x > qposi) ST[kb][g2 * 8 + 0] = -1e30f; if (pa.y > qposi) ST[kb][g2 * 8 + 1] = -1e30f; \
          if (pa.z > qposi) ST[kb][g2 * 8 + 2] = -1e30f; if (pa.w > qposi) ST[kb][g2 * 8 + 3] = -1e30f; \
          if (pb.x > qposi) ST[kb][g2 * 8 + 4] = -1e30f; if (pb.y > qposi) ST[kb][g2 * 8 + 5] = -1e30f; \
          if (pb.z > qposi) ST[kb][g2 * 8 + 6] = -1e30f; if (pb.w > qposi) ST[kb][g2 * 8 + 7] = -1e30f; \
        }                                                                    \
      }                                                                      \
    }
#define SOFTMAX_PV(ST, VB)                                                   \
    {                                                                        \
      const bf16_t* cV = sVV + (VB) * 64 * VS_;                              \
      float mx = ST[0][0];                                                   \
      _Pragma("unroll") for (int q = 1; q < 16; ++q) mx = fmaxf(mx, ST[0][q]); \
      _Pragma("unroll") for (int q = 0; q < 16; ++q) mx = fmaxf(mx, ST[1][q]); \
      mx = swap32_max(mx);                                    \
      if (__builtin_amdgcn_ballot_w64(mx > mrun + 6.f) != 0ull) {            \
        const float mnew = fmaxf(mrun, mx);                                  \
        const float alpha = __builtin_amdgcn_exp2f(mrun - mnew);             \
        mrun = mnew; lsum *= alpha;                                          \
        _Pragma("unroll") for (int q = 0; q < 16; ++q) { ot[0][q] *= alpha; ot[1][q] *= alpha; } \
      }                                                                      \
      bf16x8 pf[2][2];                                                       \
      _Pragma("unroll") for (int kb = 0; kb < 2; ++kb) {                     \
        float pv[16];                                                        \
        _Pragma("unroll") for (int q = 0; q < 16; ++q) { pv[q] = __builtin_amdgcn_exp2f(ST[kb][q] - mrun); lsum += pv[q]; } \
        _Pragma("unroll") for (int s2 = 0; s2 < 2; ++s2) {                   \
          u32x4 o;                                                           \
          o.x = pack2(pv[8 * s2 + 0], pv[8 * s2 + 1]); o.y = pack2(pv[8 * s2 + 2], pv[8 * s2 + 3]); \
          o.z = pack2(pv[8 * s2 + 4], pv[8 * s2 + 5]); o.w = pack2(pv[8 * s2 + 6], pv[8 * s2 + 7]); \
          pf[kb][s2] = __builtin_bit_cast(bf16x8, o);                        \
        }                                                                    \
      }                                                                      \
      _Pragma("unroll") for (int db = 0; db < 2; ++db)                       \
      _Pragma("unroll") for (int kb = 0; kb < 2; ++kb)                       \
      _Pragma("unroll") for (int s2 = 0; s2 < 2; ++s2) {                     \
        const bf16x8 a = *(const bf16x8*)(cV + (32 * db + r) * VS_ + 32 * kb + 16 * s2 + 8 * h); \
        ot[db] = MFMA(a, pf[kb][s2], ot[db]);                                \
      }                                                                      \
    }
#define FAST_STEP(SC, SN, KB, VB)                                            \
    {                                                                        \
      const bf16_t* cK = sK + (KB) * 64 * KS_;                               \
      const bf16_t* cV = sVV + (VB) * 64 * VS_;                              \
      float mx = SC[0][0];                                                   \
      _Pragma("unroll") for (int q = 1; q < 16; ++q) mx = fmaxf(mx, SC[0][q]); \
      _Pragma("unroll") for (int q = 0; q < 16; ++q) mx = fmaxf(mx, SC[1][q]); \
      mx = swap32_max(mx);                                    \
      if (__builtin_amdgcn_ballot_w64(mx > mrun + 6.f) != 0ull) {            \
        const float mnew = fmaxf(mrun, mx);                                  \
        const float alpha = __builtin_amdgcn_exp2f(mrun - mnew);             \
        mrun = mnew; lsum *= alpha;                                          \
        _Pragma("unroll") for (int q = 0; q < 16; ++q) { ot[0][q] *= alpha; ot[1][q] *= alpha; } \
      }                                                                      \
      _Pragma("unroll") for (int q = 0; q < 16; ++q) { SN[0][q] = 0.f; SN[1][q] = 0.f; } \
      float pv[32];                                                          \
      bf16x8 kf[12];                                                         \
      _Pragma("unroll") for (int st0 = 0; st0 < 3; ++st0) kf[st0] = *(const bf16x8*)(cK + (32 * (st0 & 1) + pr) * KS_ + (st0 >> 1) * 16 + h * 8); \
      __builtin_amdgcn_sched_barrier(0);                                     \
      _Pragma("unroll") for (int step = 0; step < 12; ++step) {              \
        const int kb = step & 1, ks = step >> 1;                             \
        if (step + 3 < 12) kf[step + 3] = *(const bf16x8*)(cK + (32 * ((step + 3) & 1) + pr) * KS_ + ((step + 3) >> 1) * 16 + h * 8); \
        SN[kb] = MFMA(kf[step], qf[ks], SN[kb]);                             \
        const int e0 = (step < 8) ? 3 * step : 24 + 2 * (step - 8);          \
        const int ne = (step < 8) ? 3 : 2;                                   \
        _Pragma("unroll") for (int e = 0; e < 3; ++e) if (e < ne) {          \
          const int ee = e0 + e;                                             \
          pv[ee] = __builtin_amdgcn_exp2f(SC[ee >> 4][ee & 15] - mrun); lsum += pv[ee]; \
        }                                                                    \
        __builtin_amdgcn_sched_barrier(0);                                   \
      }                                                                      \
      _Pragma("unroll") for (int kb = 0; kb < 2; ++kb)                       \
      _Pragma("unroll") for (int s2 = 0; s2 < 2; ++s2) {                     \
        u32x4 o;                                                             \
        const int b0 = kb * 16 + 8 * s2;                                     \
        o.x = pack2(pv[b0 + 0], pv[b0 + 1]); o.y = pack2(pv[b0 + 2], pv[b0 + 3]); \
        o.z = pack2(pv[b0 + 4], pv[b0 + 5]); o.w = pack2(pv[b0 + 6], pv[b0 + 7]); \
        const bf16x8 pfr = __builtin_bit_cast(bf16x8, o);                    \
        _Pragma("unroll") for (int db = 0; db < 2; ++db) {                   \
          const bf16x8 a = *(const bf16x8*)(cV + (32 * db + r) * VS_ + 32 * kb + 16 * s2 + 8 * h); \
          ot[db] = MFMA(a, pfr, ot[db]);                                     \
        }                                                                    \
      }                                                                      \
    }
    const int ntl = nt - 1;
    f32x16 ot[2];
#pragma unroll
    for (int q = 0; q < 16; ++q) { ot[0][q] = 0.f; ot[1][q] = 0.f; }
    float mrun = -1e30f, lsum = 0.f;
    f32x16 stA[2], stB[2];
    ALOAD(0)
    ASTORE(0, 0)
    ALOAD(1)
    __syncthreads();
    QK_TILE(stA, 0, 0)
    ASTORE(1, 1)
    __syncthreads();
    int vb = 0;
    int kt = 0;
    for (; kt + 4 < nt; kt += 2) {
      {
        ALOAD(kt + 2)
        FAST_STEP(stA, stB, 1, vb)
        const int vb2 = (vb == 0) ? 2 : (vb - 1);
        ASTORE(0, vb2)
        __syncthreads();
        vb = (vb == 2) ? 0 : (vb + 1);
      }
      {
        ALOAD(kt + 3)
        FAST_STEP(stB, stA, 0, vb)
        const int vb2 = (vb == 0) ? 2 : (vb - 1);
        ASTORE(1, vb2)
        __syncthreads();
        vb = (vb == 2) ? 0 : (vb + 1);
      }
    }
    for (; kt < nt; kt += 2) {
      {
        const int kn = (kt + 2 < nt) ? (kt + 2) : ntl;
        ALOAD(kn)
        const int k1t = (kt + 1 < nt) ? (kt + 1) : ntl;
        QK_TILE(stB, 1, k1t)
        SOFTMAX_PV(stA, vb)
        const int vb2 = (vb == 0) ? 2 : (vb - 1);
        ASTORE(0, vb2)
        __syncthreads();
        vb = (vb == 2) ? 0 : (vb + 1);
      }
      {
        const int kn = (kt + 3 < nt) ? (kt + 3) : ntl;
        ALOAD(kn)
        const int k1t = (kt + 2 < nt) ? (kt + 2) : ntl;
        QK_TILE(stA, 0, k1t)
        SOFTMAX_PV(stB, vb)
        const int vb2 = (vb == 0) ? 2 : (vb - 1);
        ASTORE(1, vb2)
        __syncthreads();
        vb = (vb == 2) ? 0 : (vb + 1);
      }
    }
#undef ALOAD
#undef ASTORE
#undef QK_TILE
#undef SOFTMAX_PV
#undef FAST_STEP
    lsum += __shfl_xor(lsum, 32);
    const float inv = 1.f / lsum;
    bf16_t* op = AO + (size_t)qrow * D + hd * 64;
#pragma unroll
    for (int db = 0; db < 2; ++db)
#pragma unroll
      for (int g4 = 0; g4 < 4; ++g4) {
        const int d = 32 * db + 8 * g4 + 4 * h;
        *(uint2*)(op + d) = make_uint2(pack2(ot[db][g4 * 4] * inv, ot[db][g4 * 4 + 1] * inv), pack2(ot[db][g4 * 4 + 2] * inv, ot[db][g4 * 4 + 3] * inv));
      }
  }
}


#define XB_TMO      128
#define XB_XCNT(j)  (256  + 64 * (j))
#define XB_XSUB(j)  (1280 + 64 * (j))
#define XB_XGEN(j)  (2304 + 64 * (j))
#define XB_TOP      3328
#define XB_TOPGEN   3392
#define XCD_BAR_WORDS 3456
#define XB_SPIN_CAP (1u << 18)
#define LAS __attribute__((address_space(3)))
DI unsigned xb_ld(unsigned* p) { return __hip_atomic_load(p, __ATOMIC_RELAXED, __HIP_MEMORY_SCOPE_AGENT); }
DI unsigned xb_add(unsigned* p, unsigned v) { return __hip_atomic_fetch_add(p, v, __ATOMIC_RELAXED, __HIP_MEMORY_SCOPE_AGENT); }
DI unsigned xb_xcc_id() { return (unsigned)__builtin_amdgcn_s_getreg((3 << 11) | 20) & 0xFu; }
#define XB_SPIN(cond, bar) do { unsigned _sp = 0; while (cond) { __builtin_amdgcn_s_sleep(1); \
    if ((++_sp & 255u) == 0u) { if (xb_ld(&(bar)[XB_TMO])) break; if (_sp > XB_SPIN_CAP) { atomicAdd(&(bar)[XB_TMO], 1u); break; } } } } while (0)
struct XcdBarrier { unsigned* bar; unsigned x; volatile LAS unsigned* st; };
DI XcdBarrier xcd_barrier_post(unsigned* bar, volatile LAS unsigned* st) {
  XcdBarrier b; b.bar = bar; b.x = xb_xcc_id(); b.st = st;
  if (__builtin_amdgcn_workitem_id_x() == 0) (void)xb_add(&bar[XB_XCNT(b.x)], 1u);
  return b;
}
DI void xcd_barrier_complete(unsigned* bar, unsigned x, unsigned& nloc, unsigned& nx) {
  const unsigned G = gridDim.x;
  unsigned sum, cnt, mine, sp = 0u;
  for (;;) {
    sum = 0u; cnt = 0u; mine = 0u;
#pragma unroll
    for (unsigned j = 0; j < 16; ++j) { const unsigned c = xb_ld(&bar[XB_XCNT(j)]); sum += c; cnt += (c > 0u) ? 1u : 0u; mine = (j == x) ? c : mine; }
    if (sum == G) break;
    __builtin_amdgcn_s_sleep(1);
    if ((++sp & 255u) == 0u) { if (xb_ld(&bar[XB_TMO])) break; if (sp > XB_SPIN_CAP) { atomicAdd(&bar[XB_TMO], 1u); break; } }
  }
  nloc = mine > 0u ? mine : 1u; nx = cnt > 0u ? cnt : 1u;
}
DI void xcd_barrier(const XcdBarrier& b) {
  asm volatile("s_waitcnt vmcnt(0)" ::: "memory");
  __syncthreads();
  if (__builtin_amdgcn_workitem_id_x() == 0) {
    unsigned* bar = b.bar;
    __builtin_amdgcn_s_waitcnt(0);
    unsigned nloc = b.st[0], nx = b.st[1];
    if (nloc == 0u) { xcd_barrier_complete(bar, b.x, nloc, nx); b.st[0] = nloc; b.st[1] = nx; }
    const unsigned old = xb_add(&bar[XB_XSUB(b.x)], 1u);
    const unsigned gen = old / nloc;
    if (old + 1u == (gen + 1u) * nloc) {
      __builtin_amdgcn_fence(__ATOMIC_RELEASE, "agent");
      asm volatile("s_waitcnt vmcnt(0)" ::: "memory");
      const unsigned og = xb_add(&bar[XB_TOP], 1u);
      const unsigned tg = og / nx;
      if (og + 1u == (tg + 1u) * nx) xb_add(&bar[XB_TOPGEN], 1u);
      else XB_SPIN(xb_ld(&bar[XB_TOPGEN]) == tg, bar);
      __builtin_amdgcn_fence(__ATOMIC_ACQUIRE, "agent");
      xb_add(&bar[XB_XGEN(b.x)], 1u);
      asm volatile("s_waitcnt vmcnt(0)" ::: "memory");
    } else {
      XB_SPIN(xb_ld(&bar[XB_XGEN(b.x)]) == gen, bar);
      __builtin_amdgcn_fence(__ATOMIC_ACQUIRE, "agent");
      asm volatile("s_waitcnt vmcnt(0)" ::: "memory");
    }
  }
  __syncthreads();
}

enum { OP_PREP = 0, OP_NORM0, OP_WIN, OP_CONV, OP_GATES, OP_SCAN1, OP_SCAN2, OP_OUTPROJ, OP_FFNNORM, OP_PEERQ, OP_TOPK, OP_EXP,
       OP_DOWN, OP_LNORM, OP_UP, OP_ATTN };
constexpr int NPH = 34;
__device__ const unsigned char PROG[NPH][2] = {
  {OP_PREP, 0}, {OP_NORM0, 0},
  {OP_WIN, 0}, {OP_CONV, 0}, {OP_GATES, 0}, {OP_SCAN2, 0}, {OP_OUTPROJ, 0}, {OP_FFNNORM, 0}, {OP_TOPK, 0}, {OP_EXP, 0},
  {OP_WIN, 1}, {OP_CONV, 1}, {OP_GATES, 1}, {OP_SCAN2, 1}, {OP_OUTPROJ, 1}, {OP_FFNNORM, 1}, {OP_TOPK, 1}, {OP_EXP, 1},
  {OP_DOWN, 2}, {OP_LNORM, 2}, {OP_UP, 2}, {OP_ATTN, 2}, {OP_OUTPROJ, 2}, {OP_FFNNORM, 2}, {OP_TOPK, 2}, {OP_EXP, 2},
  {OP_DOWN, 3}, {OP_LNORM, 3}, {OP_UP, 3}, {OP_ATTN, 3}, {OP_OUTPROJ, 3}, {OP_FFNNORM, 3}, {OP_TOPK, 3}, {OP_EXP, 3}};

template <bool COOP>
__global__ void __launch_bounds__(256, 2) yoco_mega(Params p, int lo, int hi) {
  __shared__ __attribute__((aligned(16))) char smem[SMEM_TOTAL];
  const WS w = make_ws(p.ws);
  if (TIDX() == 0) {
    TJob* sj = (TJob*)(smem + SMEM_MAIN);
#pragma unroll
    for (int q = 0; q < NJOBS; ++q) sj[q] = p.jobs[q];
    *(uint4*)(smem + SMEM_MAIN + 2032) = make_uint4(0u, 0u, 0u, 0u);
  }
  __syncthreads();
  XcdBarrier xb;
  if (COOP) xb = xcd_barrier_post((unsigned*)(p.ws + OFF_BAR), (volatile LAS unsigned*)(smem + SMEM_MAIN + 2032));
  if (COOP && hi > 100000) cg::this_grid().sync();
  for (int ph = lo; ph < hi; ++ph) {
    const int op = PROG[ph][0], l = PROG[ph][1];
    const int nrep = ((REPMASK >> op) & 1) ? 2 : 1;
    for (int rep = 0; rep < nrep; ++rep)
    switch (op) {
      case OP_PREP: if ((OPMASK >> OP_PREP) & 1) { phase_prep(p, w, smem); } break;
      case OP_NORM0: if ((OPMASK >> OP_NORM0) & 1) { phase_norm_rows<false>(p.x, p.norm_mix_g, w.MODS, w.MODS + 1024, 6144, w.H); } break;
      case OP_WIN: if ((OPMASK >> OP_WIN) & 1) { phase_win(p, w, l, smem); } break;
      case OP_CONV: if ((OPMASK >> OP_CONV) & 1) { phase_conv(p, w, l); } break;
      case OP_GATES: if ((OPMASK >> OP_GATES) & 1) { phase_gates(p, w, l, smem); } break;
      case OP_SCAN1: if ((OPMASK >> OP_SCAN1) & 1) { phase_scan1(w); } break;
      case OP_SCAN2: if ((OPMASK >> OP_SCAN2) & 1) { phase_scan2(w); } break;
      case OP_OUTPROJ: if ((OPMASK >> OP_OUTPROJ) & 1) { phase_outproj(p, w, l, smem, rep > 0); } break;
      case OP_FFNNORM: if ((OPMASK >> OP_FFNNORM) & 1) { phase_norm_rows<true>(w.X, p.norm_ffn_g + l * 1024, w.MODS + l * 2 * 6144 + 3072, w.MODS + l * 2 * 6144 + 4096, 6144, w.H); } break;
      case OP_PEERQ: if ((OPMASK >> OP_PEERQ) & 1) { phase_peerq(w, l, smem); } break;
      case OP_TOPK: if ((OPMASK >> OP_TOPK) & 1) { phase_topk(p, w, l, smem); } break;
      case OP_EXP: if ((OPMASK >> OP_EXP) & 1) { phase_exp(p, w, l, rep > 0); } break;
      case OP_DOWN: if ((OPMASK >> OP_DOWN) & 1) { phase_down(w, l, smem); } break;
      case OP_LNORM: if ((OPMASK >> OP_LNORM) & 1) { phase_lnorm(p, w, l); } break;
      case OP_UP: if ((OPMASK >> OP_UP) & 1) { phase_up(w, l, smem); } break;
      case OP_ATTN: if ((OPMASK >> OP_ATTN) & 1) { phase_attn(p, w, smem); } break;
      default: break;
    }
    if (COOP) { if (ph + 1 < hi) { xcd_barrier(xb); for (int q = 0; q < SYNCX; ++q) xcd_barrier(xb); } }
  }
}

static void add_job(Params& P, int& nj, int& tile, const float* src, bf16_t* dst, int K, int N, int ldd, int mode, int rowbase) {
  TJob& j = P.jobs[nj++];
  j.src = src; j.dst = dst; j.K = K; j.N = N; j.ldd = ldd; j.mode = mode; j.rowbase = rowbase; j.tile0 = tile;
  j.ntiles = (K / 64) * ((N + 63) / 64); j.pad = 0; tile += j.ntiles;
}

extern "C" void kernel_launch(void* const* d_in, const int* in_sizes, int n_in, void* d_out, int out_size, void* d_ws, size_t ws_size,
                              hipStream_t stream) {
  static Params P;
  memset(&P, 0, sizeof(P));
  const float* const* f = (const float* const*)d_in;
  P.x = f[0]; P.c = f[1]; P.pos = (const int*)d_in[2];
  P.ada_w = f[3]; P.ada_b = f[4]; P.norm_mix_g = f[5]; P.norm_ffn_g = f[6];
  P.lru_w_in = f[7]; P.lru_conv_w = f[8]; P.lru_conv_b = f[9]; P.lru_wa = f[10]; P.lru_ba = f[11]; P.lru_wx = f[12]; P.lru_bx = f[13];
  P.lru_lambda = f[14]; P.lru_w_out = f[15];
  P.kv_ada_w = f[16]; P.kv_ada_b = f[17]; P.kv_norm_g = f[18]; P.w_dkv = f[19]; P.w_kr = f[20]; P.kv_latent_g = f[21]; P.w_uk = f[22]; P.w_uv = f[23];
  P.w_dq = f[24]; P.q_latent_g = f[25]; P.w_uq = f[26]; P.w_o = f[27];
  P.peer_w_q = f[28]; P.peer_keys = f[29]; P.peer_u = f[30]; P.peer_v = f[31]; P.final_g = f[32];
  P.out = (float*)d_out; P.ws = (char*)d_ws;
  bf16_t* W = (bf16_t*)((char*)d_ws + OFF_W);
  int nj = 0, tile = 0;
  for (int l = 0; l < 2; ++l) add_job(P, nj, tile, P.lru_w_in + (size_t)l * 1024 * 2048, W + W_WIN + (size_t)l * 2048 * 1024, 1024, 2048, 1024, 0, 0);
  for (int l = 0; l < 2; ++l)
    for (int hh = 0; hh < 4; ++hh) {
      add_job(P, nj, tile, P.lru_wa + (size_t)(l * 4 + hh) * 65536, W + W_GATE + (size_t)l * 2048 * 256, 256, 256, 256, 1, hh * 256);
      add_job(P, nj, tile, P.lru_wx + (size_t)(l * 4 + hh) * 65536, W + W_GATE + (size_t)l * 2048 * 256, 256, 256, 256, 2, hh * 256);
    }
  for (int l = 0; l < 2; ++l) add_job(P, nj, tile, P.lru_w_out + (size_t)l * 1024 * 1024, W + W_WOUT + (size_t)l * 1024 * 1024, 1024, 1024, 1024, 0, 0);
  add_job(P, nj, tile, P.w_dkv, W + W_DKV, 1024, 256, 1024, 0, 0);
  add_job(P, nj, tile, P.w_kr, W + W_DKV, 1024, 32, 1024, 0, 256);
  add_job(P, nj, tile, P.w_uk, W + W_UKV, 256, 1024, 256, 0, 0);
  add_job(P, nj, tile, P.w_uv, W + W_UKV, 256, 1024, 256, 0, 1024);
  for (int j = 0; j < 2; ++j) add_job(P, nj, tile, P.w_dq + (size_t)j * 1024 * 384, W + W_DQ + (size_t)j * 384 * 1024, 1024, 384, 1024, 0, 0);
  for (int j = 0; j < 2; ++j) add_job(P, nj, tile, P.w_uq + (size_t)j * 384 * 1536, W + W_UQ + (size_t)j * 1536 * 384, 384, 1536, 384, 0, 0);
  for (int j = 0; j < 2; ++j) add_job(P, nj, tile, P.w_o + (size_t)j * 1024 * 1024, W + W_WO + (size_t)j * 1024 * 1024, 1024, 1024, 1024, 0, 0);
  for (int l = 0; l < 4; ++l) add_job(P, nj, tile, P.peer_w_q + (size_t)l * 1024 * 2048, W + W_PQ + (size_t)l * 2048 * 1024, 1024, 2048, 1024, 0, 0);
  P.n_tconv = tile;
  static int grid_blocks = 0;
  if (!grid_blocks) {
    int dev = 0, cus = 0, per_cu = 0;
    hipGetDevice(&dev);
    hipDeviceGetAttribute(&cus, hipDeviceAttributeMultiprocessorCount, dev);
    hipOccupancyMaxActiveBlocksPerMultiprocessor(&per_cu, yoco_mega<true>, 256, 0);
    if (per_cu > 2) per_cu = 2;
    if (per_cu < 1) per_cu = 1;
    grid_blocks = cus * per_cu;
  }
#if MULTI
  for (int ph = 0; ph < NPH; ++ph) hipLaunchKernelGGL((yoco_mega<false>), dim3(grid_blocks), dim3(256), 0, stream, P, ph, ph + 1);
#else
  int lo = 0, hi = NPH;
  void* args[] = {&P, &lo, &hi};
  (void)hipMemsetAsync((char*)d_ws + OFF_BAR, 0, XCD_BAR_WORDS * 4, stream);
  hipError_t e = hipLaunchCooperativeKernel((void*)yoco_mega<true>, dim3(grid_blocks), dim3(256), args, 0, stream);
  if (e != hipSuccess) fprintf(stderr, "cooperative launch failed: %s (grid %d)\n", hipGetErrorString(e), grid_blocks);
#endif
}
```

```cpp
#include <hip/hip_runtime.h>
#include <hip/hip_cooperative_groups.h>
#include <stdint.h>
#include <string.h>
#include <stdio.h>
namespace cg = cooperative_groups;

#ifndef MULTI
#define MULTI 0
#endif
#ifndef REPMASK
#define REPMASK 0x0
#endif
#ifndef SYNCX
#define SYNCX 0
#endif
#ifndef OPMASK
#define OPMASK 0xFFFF
#endif

#define DI __device__ __forceinline__
DI int TIDX() { int t = (int)__builtin_amdgcn_workitem_id_x(); asm volatile("" : "+v"(t)); return t; }
typedef unsigned short bf16_t;
typedef __attribute__((ext_vector_type(8))) short bf16x8;
typedef __attribute__((ext_vector_type(16))) float f32x16;
typedef unsigned u32x4 __attribute__((ext_vector_type(4)));
typedef __bf16 bf16x2_t __attribute__((ext_vector_type(2)));
typedef float f32x2_t __attribute__((ext_vector_type(2)));
typedef _Float16 half_t;
typedef _Float16 h16x2_t __attribute__((ext_vector_type(2)));
#define MFMA(a, b, c) __builtin_amdgcn_mfma_f32_32x32x16_bf16((a), (b), (c), 0, 0, 0)

constexpr int T = 16384, D = 1024, SEQ = 8192;
constexpr size_t MB = 1048576;
constexpr size_t OFF_X = 0, OFF_H = 64 * MB, OFF_SCR = 96 * MB, OFF_QP = 352 * MB, OFF_PIDX = 416 * MB, OFF_PG = 424 * MB,
                 OFF_MODS = 432 * MB, OFF_SUM = 433 * MB, OFF_BAR = 435 * MB, OFF_W = 436 * MB, OFF_TU = 480 * MB, OFF_TV = 544 * MB, OFF_SU = 608 * MB, OFF_SV = 609 * MB;
constexpr size_t SA_G = 0, SA_REC = 32 * MB, SA_XC = 64 * MB, SA_AA = 96 * MB, SA_BB = 160 * MB, SA_YG = 224 * MB;
constexpr size_t SB_KN = 0, SB_VT = 32 * MB, SB_KR = 64 * MB, SB_CKV = 65 * MB, SB_KVRAW = 73 * MB, SB_HKV = 97 * MB,
                 SB_QLRAW = 129 * MB, SB_QL = 153 * MB, SB_QM = 165 * MB, SB_AO = 213 * MB;
constexpr size_t W_WIN = 0, W_GATE = W_WIN + 2 * 2048 * 1024, W_WOUT = W_GATE + 2 * 2048 * 256, W_DKV = W_WOUT + 2 * 1024 * 1024,
                 W_UKV = W_DKV + 384 * 1024, W_DQ = W_UKV + 2048 * 256, W_UQ = W_DQ + 2 * 384 * 1024, W_WO = W_UQ + 2 * 1536 * 384,
                 W_PQ = W_WO + 2 * 1024 * 1024, W_KEYS = W_PQ + 4 * 2048 * 1024, W_END = W_KEYS + 4 * 262144;
static_assert(W_END * 2 <= 44 * MB, "weights overflow");

constexpr int NJOBS = 34;
struct TJob { const float* src; bf16_t* dst; int K, N, ldd, mode, rowbase, tile0, ntiles, pad; };
struct Params {
  const float *x, *c; const int* pos;
  const float *ada_w, *ada_b, *norm_mix_g, *norm_ffn_g;
  const float *lru_w_in, *lru_conv_w, *lru_conv_b, *lru_wa, *lru_ba, *lru_wx, *lru_bx, *lru_lambda, *lru_w_out;
  const float *kv_ada_w, *kv_ada_b, *kv_norm_g, *w_dkv, *w_kr, *kv_latent_g, *w_uk, *w_uv;
  const float *w_dq, *q_latent_g, *w_uq, *w_o;
  const float *peer_w_q, *peer_keys, *peer_u, *peer_v, *final_g;
  float* out; char* ws;
  TJob jobs[NJOBS];
  int n_tconv, pad0;
};

constexpr int SMEM_MAIN = 73728;
constexpr int SMEM_TOTAL = SMEM_MAIN + 2048;

__device__ const float ROPE_FREQ[16] = {1.0f, 0.5623413251903491f, 0.31622776601683794f, 0.1778279410038923f,
  0.1f, 0.05623413251903491f, 0.031622776601683794f, 0.01778279410038923f, 0.01f, 0.005623413251903491f,
  0.0031622776601683794f, 0.001778279410038923f, 0.001f, 0.0005623413251903491f, 0.00031622776601683794f, 0.0001778279410038923f};

DI unsigned pack2(float a, float b) {
  f32x2_t v = {a, b};
  bf16x2_t r = __builtin_convertvector(v, bf16x2_t);
  return __builtin_bit_cast(unsigned, r);
}
DI bf16_t f2bf(float a) { return (bf16_t)(pack2(a, 0.f) & 0xffffu); }
DI float bflo(unsigned u) { return __uint_as_float(u << 16); }
DI float bfhi(unsigned u) { return __uint_as_float(u & 0xffff0000u); }
DI float bf2f(bf16_t b) { return __uint_as_float(((unsigned)b) << 16); }
DI float hlo(unsigned u) { return (float)__builtin_bit_cast(h16x2_t, u).x; }
DI float hhi(unsigned u) { return (float)__builtin_bit_cast(h16x2_t, u).y; }
DI unsigned packh2(float a, float b) { h16x2_t v = {(half_t)a, (half_t)b}; return __builtin_bit_cast(unsigned, v); }
DI float dot2(unsigned a, unsigned b, float c) {
  return __builtin_amdgcn_fdot2_f32_bf16(__builtin_bit_cast(bf16x2_t, a), __builtin_bit_cast(bf16x2_t, b), c, false);
}
DI float wave_sum(float v) {
#pragma unroll
  for (int o = 32; o > 0; o >>= 1) v += __shfl_xor(v, o);
  return v;
}
DI float fast_erf(float x) {
  const float ax = fabsf(x);
  const float t = __builtin_amdgcn_rcpf(1.f + 0.3275911f * ax);
  const float poly = t * (0.254829592f + t * (-0.284496736f + t * (1.421413741f + t * (-1.453152027f + t * 1.061405429f))));
  const float e = 1.f - poly * __builtin_amdgcn_exp2f(-1.4426950408889634f * ax * ax);
  return copysignf(e, x);
}

typedef unsigned u32x2_t __attribute__((ext_vector_type(2)));
DI int swap32_sum(int a, int b) {
  const u32x2_t r = __builtin_amdgcn_permlane32_swap((unsigned)a, (unsigned)b, false, false);
  return (int)(r[0] + r[1]);
}
DI int swap16_sum(int a, int b) {
  const u32x2_t r = __builtin_amdgcn_permlane16_swap((unsigned)a, (unsigned)b, false, false);
  return (int)(r[0] + r[1]);
}
template <int CTRL> DI int dpp_mov(int x) { return __builtin_amdgcn_update_dpp(x, x, CTRL, 0xF, 0xF, false); }
DI float swap32_max(float x) {
  const u32x2_t r = __builtin_amdgcn_permlane32_swap(__float_as_uint(x), __float_as_uint(x), false, false);
  return fmaxf(__uint_as_float(r[0]), __uint_as_float(r[1]));
}
DI float gelu_f(float v) { return 0.5f * v * (1.f + fast_erf(v * 0.70710678118654752f)); }
DI float sigmoid_f(float z) { return __builtin_amdgcn_rcpf(1.f + __builtin_amdgcn_exp2f(-1.4426950408889634f * z)); }
DI void rope_sincos(float ang, float& s, float& c) {
  double rev = (double)ang * 0.15915494309189535;
  rev -= rint(rev);
  float fr = (float)rev;
  s = __builtin_amdgcn_sinf(fr);
  c = __builtin_amdgcn_cosf(fr);
}

#define GS 72
DI void gemm_tile(const bf16_t* __restrict__ A, int lda, const bf16_t* __restrict__ B, int ldb, int K,
                  bf16_t* sm, f32x16 (&acc)[2][2]) {
  const int tid = TIDX(), lane = tid & 63, wave = tid >> 6;
  const int r = lane & 31, h = lane >> 5, wm = wave >> 1, wn = wave & 1;
  const int lrow = tid >> 3, lch = tid & 7;
  u32x4 ra0_0, ra0_1, ra0_2, ra0_3, rb0_0, rb0_1, rb0_2, rb0_3, ra1_0, ra1_1, ra1_2, ra1_3, rb1_0, rb1_1, rb1_2, rb1_3;
  const bf16_t* ag = A + (size_t)lrow * lda + lch * 8;
  const bf16_t* bg = B + (size_t)lrow * ldb + lch * 8;
  const int nk = K >> 6;
#define GLOAD1(RA, RB, KO, I)                                               \
    RA##_##I = *(const u32x4*)(ag + (size_t)(I) * 32 * lda + (KO));         \
    RB##_##I = *(const u32x4*)(bg + (size_t)(I) * 32 * ldb + (KO));
#define GLOAD(RA, RB, KO) { GLOAD1(RA, RB, KO, 0) GLOAD1(RA, RB, KO, 1) GLOAD1(RA, RB, KO, 2) GLOAD1(RA, RB, KO, 3) }
#define SSTORE1(RA, RB, BUF, I)                                             \
    *(u32x4*)(sa + (BUF) * 128 * GS + soff + (I) * 32 * GS) = RA##_##I;     \
    *(u32x4*)(sb + (BUF) * 128 * GS + soff + (I) * 32 * GS) = RB##_##I;
#define SSTORE(RA, RB, BUF) { SSTORE1(RA, RB, BUF, 0) SSTORE1(RA, RB, BUF, 1) SSTORE1(RA, RB, BUF, 2) SSTORE1(RA, RB, BUF, 3) }
#define COMPUTE(BUF)                                                        \
  {                                                                         \
    const bf16_t* ca = sa + (BUF) * 128 * GS + (wm * 64 + r) * GS + h * 8;  \
    const bf16_t* cb = sb + (BUF) * 128 * GS + (wn * 64 + r) * GS + h * 8;  \
    bf16x8 fa0[4], fa1[4], fb0[4], fb1[4];                                  \
    fa0[0] = *(const bf16x8*)(ca); fa1[0] = *(const bf16x8*)(ca + 32 * GS); \
    fb0[0] = *(const bf16x8*)(cb); fb1[0] = *(const bf16x8*)(cb + 32 * GS); \
    __builtin_amdgcn_sched_barrier(0);                                      \
    _Pragma("unroll") for (int ks = 0; ks < 4; ++ks) {                      \
      if (ks < 3) {                                                         \
        fa0[ks + 1] = *(const bf16x8*)(ca + (ks + 1) * 16); fa1[ks + 1] = *(const bf16x8*)(ca + 32 * GS + (ks + 1) * 16); \
        fb0[ks + 1] = *(const bf16x8*)(cb + (ks + 1) * 16); fb1[ks + 1] = *(const bf16x8*)(cb + 32 * GS + (ks + 1) * 16); \
      }                                                                     \
      c00 = MFMA(fa0[ks], fb0[ks], c00);                                    \
      c01 = MFMA(fa0[ks], fb1[ks], c01);                                    \
      c10 = MFMA(fa1[ks], fb0[ks], c10);                                    \
      c11 = MFMA(fa1[ks], fb1[ks], c11);                                    \
      __builtin_amdgcn_sched_barrier(0);                                    \
    }                                                                       \
  }
  bf16_t* sa = sm;
  bf16_t* sb = sm + 2 * 128 * GS;
  const int soff = lrow * GS + lch * 8;
  GLOAD(ra0, rb0, 0)
  GLOAD(ra1, rb1, 64)
  f32x16 c00, c01, c10, c11;
  {
    const f32x16 z = {0.f, 0.f, 0.f, 0.f, 0.f, 0.f, 0.f, 0.f, 0.f, 0.f, 0.f, 0.f, 0.f, 0.f, 0.f, 0.f};
    c00 = z; c01 = z; c10 = z; c11 = z;
  }
  SSTORE(ra0, rb0, 0)
  if (nk > 2) { GLOAD(ra0, rb0, 128) }
  __syncthreads();
  for (int kt = 0; kt < nk; kt += 2) {
    COMPUTE(0)
    SSTORE(ra1, rb1, 1)
    if (kt + 3 < nk) { GLOAD(ra1, rb1, (kt + 3) * 64) }
    __syncthreads();
    COMPUTE(1)
    if (kt + 2 < nk) {
      SSTORE(ra0, rb0, 0)
      if (kt + 4 < nk) { GLOAD(ra0, rb0, (kt + 4) * 64) }
    }
    __syncthreads();
  }
  acc[0][0] = c00; acc[0][1] = c01; acc[1][0] = c10; acc[1][1] = c11;
#undef GLOAD
#undef GLOAD1
#undef SSTORE1
#undef SSTORE
#undef COMPUTE
}

DI void lds_mma_128(const bf16_t* sa, const bf16_t* sb, f32x16 (&acc)[2][2]) {
  const int tid = TIDX(), lane = tid & 63, wave = tid >> 6;
  const int r = lane & 31, h = lane >> 5, wm = wave >> 1, wn = wave & 1;
  const bf16_t* ca = sa + (wm * 64 + r) * GS + h * 8;
  const bf16_t* cb = sb + (wn * 64 + r) * GS + h * 8;
#pragma unroll
  for (int ks = 0; ks < 4; ++ks) {
    const bf16x8 a0 = *(const bf16x8*)(ca + ks * 16), a1 = *(const bf16x8*)(ca + 32 * GS + ks * 16);
    const bf16x8 b0 = *(const bf16x8*)(cb + ks * 16), b1 = *(const bf16x8*)(cb + 32 * GS + ks * 16);
    acc[0][0] = MFMA(a0, b0, acc[0][0]);
    acc[0][1] = MFMA(a0, b1, acc[0][1]);
    acc[1][0] = MFMA(a1, b0, acc[1][0]);
    acc[1][1] = MFMA(a1, b1, acc[1][1]);
  }
}
#define EPI_BEGIN                                                              \
  {                                                                            \
    const int _lane = TIDX() & 63, _wave = TIDX() >> 6;              \
    const int _r = _lane & 31, _h = _lane >> 5, _wm = _wave >> 1, _wn = _wave & 1; \
    _Pragma("unroll") for (int _i = 0; _i < 2; ++_i)                           \
    _Pragma("unroll") for (int _j = 0; _j < 2; ++_j)                           \
    _Pragma("unroll") for (int _q = 0; _q < 16; ++_q) {                        \
      const int trow = _wm * 64 + _i * 32 + (_q & 3) + 8 * (_q >> 2) + 4 * _h; \
      const int tcol = _wn * 64 + _j * 32 + _r;                                \
      const float val = acc[_i][_j][_q];
#define EPI_END }}


DI bool xcd_item(int it, int NT, int& mt, int& nt) {
  const int G = gridDim.x;
  if ((G & 7) != 0) { if (it >= 128 * NT) return false; mt = it / NT; nt = it - mt * NT; return true; }
  const int S = G >> 3;
  const int rnd = it / G, b = it - rnd * G;
  const int xcd = b & 7, slot = b >> 3;
  const int li = rnd * S + slot;
  if (li >= 16 * NT) return false;
  const int ml = li / NT;
  mt = 16 * xcd + ml; nt = li - ml * NT;
  return true;
}

struct WS {
  half_t* X; bf16_t* H; char* scr; bf16_t* QP; int* PIDX; float* PG; float* MODS; float* KVMODS; float* SUMA; float* SUMH;
  bf16_t* W; unsigned char* TU; unsigned char* TV; float* SU; float* SV;
};
DI WS make_ws(char* ws) {
  WS w;
  w.X = (half_t*)(ws + OFF_X); w.H = (bf16_t*)(ws + OFF_H); w.scr = ws + OFF_SCR; w.QP = (bf16_t*)(ws + OFF_QP);
  w.PIDX = (int*)(ws + OFF_PIDX); w.PG = (float*)(ws + OFF_PG); w.MODS = (float*)(ws + OFF_MODS);
  w.KVMODS = w.MODS + 4 * 2 * 6144; w.SUMA = (float*)(ws + OFF_SUM); w.SUMH = w.SUMA + 2 * 128 * 1024;
  w.W = (bf16_t*)(ws + OFF_W); w.TU = (unsigned char*)(ws + OFF_TU); w.TV = (unsigned char*)(ws + OFF_TV); w.SU = (float*)(ws + OFF_SU); w.SV = (float*)(ws + OFF_SV);
  return w;
}

DI void convert_table_item(const Params& p, const WS& w, int gid) {
  const int lane = TIDX() & 63, wave = TIDX() >> 6;
  const int which = (gid >> 10) & 1;
  const int row0 = ((gid >> 11) * 1024 + (gid & 1023)) * 16 + wave * 4;
  const float* src = which ? p.peer_v : p.peer_u;
  unsigned char* dst = which ? w.TV : w.TU;
  float* sc = which ? w.SV : w.SU;
  float4 v[4][4];
#pragma unroll
  for (int u = 0; u < 4; ++u)
#pragma unroll
    for (int i = 0; i < 4; ++i) v[u][i] = *(const float4*)(src + (size_t)(row0 + u) * 1024 + i * 256 + lane * 4);
#pragma unroll
  for (int u = 0; u < 4; ++u) {
    const int row = row0 + u;
    float am = 0.f;
#pragma unroll
    for (int i = 0; i < 4; ++i)
      am = fmaxf(am, fmaxf(fmaxf(fabsf(v[u][i].x), fabsf(v[u][i].y)), fmaxf(fabsf(v[u][i].z), fabsf(v[u][i].w))));
#pragma unroll
    for (int o = 32; o > 0; o >>= 1) am = fmaxf(am, __shfl_xor(am, o));
    const float inv = am > 0.f ? 127.f / am : 0.f;
    const int bias = which ? 128 : 0;
#pragma unroll
    for (int i = 0; i < 4; ++i) {
      const int q0 = (int)rintf(v[u][i].x * inv) + bias, q1 = (int)rintf(v[u][i].y * inv) + bias;
      const int q2 = (int)rintf(v[u][i].z * inv) + bias, q3 = (int)rintf(v[u][i].w * inv) + bias;
      *(unsigned*)(dst + (size_t)row * 1024 + i * 256 + lane * 4) =
          (unsigned)(q0 & 255) | ((unsigned)(q1 & 255) << 8) | ((unsigned)(q2 & 255) << 16) | ((unsigned)(q3 & 255) << 24);
    }
    if (lane == 0) sc[row] = am * (1.f / 127.f);
  }
}

DI void phase_prep(const Params& p, const WS& w, char* smem) {
  const int tid = TIDX(), lane = tid & 63, wave = tid >> 6;
  TJob* sj = (TJob*)(smem + SMEM_MAIN);
  const int n_mods = 416, n_tconv = p.n_tconv, n_keys = 512, n_pad = 1, n_tab = 0;
  const int total = n_mods + n_tconv + n_keys + n_pad + n_tab;
  for (int it0 = blockIdx.x; it0 < total; it0 += gridDim.x) {
    int it = it0;
    if (it < n_mods) {
      float* sc = (float*)smem;
      float* red = sc + 2048;
      for (int i = tid; i < 2048; i += 256) { float v = p.c[i]; sc[i] = v / (1.f + __expf(-v)); }
      __syncthreads();
      const int gcol = it * 64 + lane;
      const float* Wp; int ld, l = 0, j;
      if (gcol < 24576) { l = gcol / 6144; j = gcol - l * 6144; Wp = p.ada_w + (size_t)l * 1024 * 6144 + j; ld = 6144; }
      else { j = gcol - 24576; Wp = p.kv_ada_w + j; ld = 2048; l = 4; }
      float a0 = 0.f, a1 = 0.f;
      const int k0 = wave * 256;
#pragma unroll 1
      for (int kb = 0; kb < 256; kb += 32) {
        float wv[32];
#pragma unroll
        for (int k = 0; k < 32; ++k) wv[k] = Wp[(size_t)(k0 + kb + k) * ld];
#pragma unroll
        for (int k = 0; k < 32; ++k) { a0 += sc[k0 + kb + k] * wv[k]; a1 += sc[1024 + k0 + kb + k] * wv[k]; }
      }
      red[(wave * 64 + lane) * 2] = a0; red[(wave * 64 + lane) * 2 + 1] = a1;
      __syncthreads();
      if (wave == 0) {
        float s0 = 0.f, s1 = 0.f;
#pragma unroll
        for (int q = 0; q < 4; ++q) { s0 += red[(q * 64 + lane) * 2]; s1 += red[(q * 64 + lane) * 2 + 1]; }
        if (l < 4) {
          float bb = p.ada_b[l * 6144 + j];
          w.MODS[(l * 2 + 0) * 6144 + j] = s0 + bb; w.MODS[(l * 2 + 1) * 6144 + j] = s1 + bb;
        } else {
          float bb = p.kv_ada_b[j];
          w.KVMODS[j] = s0 + bb; w.KVMODS[2048 + j] = s1 + bb;
        }
      }
      __syncthreads();
      continue;
    }
    it -= n_mods;
    if (it < n_tconv) {
      int jj = 0;
      for (int q = 0; q < NJOBS; ++q) if (it >= sj[q].tile0) jj = q;
      const TJob jb = sj[jj];
      float* tile = (float*)smem;
      const int tiles_n = (jb.N + 63) >> 6;
      const int lt = it - jb.tile0;
      const int tk = lt / tiles_n, tn = lt - tk * tiles_n;
      const int k0 = tk * 64, n0 = tn * 64;
      {
        const int nl = tid & 63, kl0 = tid >> 6;
        float tv[16];
#pragma unroll
        for (int i = 0; i < 16; ++i) {
          const int kl = kl0 + 4 * i;
          tv[i] = (n0 + nl < jb.N) ? jb.src[(size_t)(k0 + kl) * jb.N + n0 + nl] : 0.f;
        }
#pragma unroll
        for (int i = 0; i < 16; ++i) tile[(kl0 + 4 * i) * 65 + nl] = tv[i];
      }
      __syncthreads();
      {
        const int nl = tid >> 2, kq = tid & 3;
        if (n0 + nl < jb.N) {
          const int n = jb.rowbase + n0 + nl;
          const int drow = (jb.mode == 0) ? n : (64 * (n >> 5) + 32 * (jb.mode - 1) + (n & 31));
          unsigned pk[8];
#pragma unroll
          for (int e = 0; e < 8; ++e) pk[e] = pack2(tile[(kq * 16 + 2 * e) * 65 + nl], tile[(kq * 16 + 2 * e + 1) * 65 + nl]);
          uint4* dp = (uint4*)(jb.dst + (size_t)drow * jb.ldd + k0 + kq * 16);
          dp[0] = make_uint4(pk[0], pk[1], pk[2], pk[3]);
          dp[1] = make_uint4(pk[4], pk[5], pk[6], pk[7]);
        }
      }
      __syncthreads();
      continue;
    }
    it -= n_tconv;
    if (it < n_keys) {
      const size_t e = (size_t)it * 2048 + tid * 8;
      const float4 v0 = *(const float4*)(p.peer_keys + e), v1 = *(const float4*)(p.peer_keys + e + 4);
      *(uint4*)(w.W + W_KEYS + e) = make_uint4(pack2(v0.x, v0.y), pack2(v0.z, v0.w), pack2(v1.x, v1.y), pack2(v1.z, v1.w));
      continue;
    }
    it -= n_keys;
    if (it < n_pad) {
      uint4* dp = (uint4*)(w.W + W_DKV + 288 * 1024);
      for (int i = tid; i < 96 * 1024 / 8; i += 256) dp[i] = make_uint4(0, 0, 0, 0);
      continue;
    }
    it -= n_pad;
    convert_table_item(p, w, it);
  }
}

template <bool HALF_IN>
DI void phase_norm_rows(const void* __restrict__ Xv, const float* __restrict__ g, const float* __restrict__ shift0,
                        const float* __restrict__ scale0, int bstride, bf16_t* __restrict__ out) {
  const int lane = TIDX() & 63, wave = TIDX() >> 6;
  for (int it = blockIdx.x; it < T / 4; it += gridDim.x) {
    const int t = it * 4 + wave, b = t >> 13;
    float4 v[4]; float ss = 0.f;
#pragma unroll
    for (int i = 0; i < 4; ++i) {
      if (HALF_IN) {
        const uint2 hv = *(const uint2*)((const half_t*)Xv + (size_t)t * D + i * 256 + lane * 4);
        v[i] = make_float4(hlo(hv.x), hhi(hv.x), hlo(hv.y), hhi(hv.y));
      } else {
        v[i] = *(const float4*)((const float*)Xv + (size_t)t * D + i * 256 + lane * 4);
      }
      ss += v[i].x * v[i].x + v[i].y * v[i].y + v[i].z * v[i].z + v[i].w * v[i].w;
    }
    ss = wave_sum(ss);
    const float rinv = rsqrtf(ss * (1.f / 1024.f) + 1e-6f);
#pragma unroll
    for (int i = 0; i < 4; ++i) {
      const int col = i * 256 + lane * 4;
      const float4 gg = *(const float4*)(g + col);
      const float4 sc = *(const float4*)(scale0 + b * bstride + col);
      const float4 sh = *(const float4*)(shift0 + b * bstride + col);
      const float y0 = v[i].x * rinv * gg.x * (1.f + sc.x) + sh.x, y1 = v[i].y * rinv * gg.y * (1.f + sc.y) + sh.y;
      const float y2 = v[i].z * rinv * gg.z * (1.f + sc.z) + sh.z, y3 = v[i].w * rinv * gg.w * (1.f + sc.w) + sh.w;
      *(uint2*)(out + (size_t)t * D + col) = make_uint2(pack2(y0, y1), pack2(y2, y3));
    }
  }
}

DI void phase_win(const Params& p, const WS& w, int l, char* smem) {
  int bg = 0 + blockIdx.x;
  bf16_t* G = (bf16_t*)(w.scr + SA_G); bf16_t* REC = (bf16_t*)(w.scr + SA_REC);
  const bf16_t* Wt = w.W + W_WIN + (size_t)l * 2048 * 1024;
  for (int it = blockIdx.x; it < 128 * 16 + (int)gridDim.x; it += gridDim.x) {
    int mt, nt;
    if (!xcd_item(it, 16, mt, nt)) break;
    const int m0 = mt * 128, n0 = nt * 128;
    f32x16 acc[2][2];
    gemm_tile(w.H + (size_t)m0 * D, D, Wt + (size_t)n0 * D, D, D, (bf16_t*)smem, acc);
    if (n0 < 1024) {
      EPI_BEGIN G[(size_t)(m0 + trow) * D + n0 + tcol] = f2bf(gelu_f(val)); EPI_END
    } else {
      EPI_BEGIN REC[(size_t)(m0 + trow) * D + (n0 - 1024) + tcol] = f2bf(val); EPI_END
    }
    if (l == 0 && bg < 2048) { convert_table_item(p, w, bg); bg += gridDim.x; }
  }
  if (l == 0) for (; bg < 2048; bg += gridDim.x) convert_table_item(p, w, bg);
}
DI void phase_conv(const Params& p, const WS& w, int l) {
  const bf16_t* REC = (const bf16_t*)(w.scr + SA_REC); bf16_t* XC = (bf16_t*)(w.scr + SA_XC);
  const float* cw = p.lru_conv_w + l * 4 * 1024; const float* cb = p.lru_conv_b + l * 1024;
  for (int it = blockIdx.x; it < T * 128 / 256; it += gridDim.x) {
    const int gi = it * 256 + TIDX();
    const int t = gi >> 7, c0 = (gi & 127) * 8, s = t & (SEQ - 1);
    float a[8];
    {
      const float4 b0 = *(const float4*)(cb + c0), b1 = *(const float4*)(cb + c0 + 4);
      a[0] = b0.x; a[1] = b0.y; a[2] = b0.z; a[3] = b0.w; a[4] = b1.x; a[5] = b1.y; a[6] = b1.z; a[7] = b1.w;
    }
#pragma unroll
    for (int k = 0; k < 4; ++k) {
      const int ds = 3 - k;
      if (s - ds >= 0) {
        const uint4 rv = *(const uint4*)(REC + (size_t)(t - ds) * D + c0);
        const float4 w0 = *(const float4*)(cw + k * 1024 + c0), w1 = *(const float4*)(cw + k * 1024 + c0 + 4);
        a[0] += bflo(rv.x) * w0.x; a[1] += bfhi(rv.x) * w0.y; a[2] += bflo(rv.y) * w0.z; a[3] += bfhi(rv.y) * w0.w;
        a[4] += bflo(rv.z) * w1.x; a[5] += bfhi(rv.z) * w1.y; a[6] += bflo(rv.w) * w1.z; a[7] += bfhi(rv.w) * w1.w;
      }
    }
    *(uint4*)(XC + (size_t)t * D + c0) = make_uint4(pack2(a[0], a[1]), pack2(a[2], a[3]), pack2(a[4], a[5]), pack2(a[6], a[7]));
  }
}
DI void phase_gates(const Params& p, const WS& w, int l, char* smem) {
  int bg = 2048 + blockIdx.x;
  const bf16_t* XC = (const bf16_t*)(w.scr + SA_XC);
  bf16_t* AA = (bf16_t*)(w.scr + SA_AA); bf16_t* BB = (bf16_t*)(w.scr + SA_BB);
  const bf16_t* Wt = w.W + W_GATE + (size_t)l * 2048 * 256;
  const float* ba = p.lru_ba + l * 1024; const float* bx = p.lru_bx + l * 1024; const float* lam = p.lru_lambda + l * 1024;
  const int lane = TIDX() & 63, wave = TIDX() >> 6, r = lane & 31, h = lane >> 5, wm = wave >> 1, wn = wave & 1;
  for (int it = blockIdx.x; it < 128 * 16 + (int)gridDim.x; it += gridDim.x) {
    int mt, nt;
    if (!xcd_item(it, 16, mt, nt)) break;
    const int m0 = mt * 128, n0 = nt * 128;
    const int head = n0 >> 9;
    const int c = 32 * ((n0 >> 6) + wn) + r;
    const float bac = ba[c], bxc = bx[c];
    const float lamc = lam[c];
    f32x16 acc[2][2];
    gemm_tile(XC + (size_t)m0 * D + head * 256, D, Wt + (size_t)n0 * 256, 256, 256, (bf16_t*)smem, acc);
    const float sp = log1pf(__expf(-lamc));
#pragma unroll
    for (int i = 0; i < 2; ++i)
#pragma unroll
      for (int q = 0; q < 16; ++q) {
        const int row = m0 + wm * 64 + i * 32 + (q & 3) + 8 * (q >> 2) + 4 * h;
        const float rg = sigmoid_f(acc[i][0][q] + bac), ig = sigmoid_f(acc[i][1][q] + bxc);
        const float la = -8.f * rg * sp;
        const float av = __builtin_amdgcn_exp2f(1.4426950408889634f * la);
        const float xc = bf2f(XC[(size_t)row * D + c]);
        const float bv = __builtin_amdgcn_sqrtf(fmaxf(1.f - av * av, 0.f)) * (ig * xc);
        const bf16_t omh = f2bf(1.f - av), bvh = f2bf(bv);
        AA[(size_t)row * D + c] = omh; BB[(size_t)row * D + c] = bvh;
        acc[i][0][q] = 1.f - bf2f(omh); acc[i][1][q] = bf2f(bvh);
      }
    {
      float sa[8], sh[8];
#pragma unroll
      for (int i = 0; i < 2; ++i)
#pragma unroll
        for (int g = 0; g < 4; ++g) {
          float hh = 0.f, ap = 1.f;
#pragma unroll
          for (int e = 0; e < 4; ++e) { const float a = acc[i][0][g * 4 + e], bb = acc[i][1][g * 4 + e]; hh = a * hh + bb; ap *= a; }
          sa[i * 4 + g] = ap; sh[i * 4 + g] = hh;
        }
      float HH = 0.f, AP = 1.f;
#pragma unroll
      for (int sgi = 0; sgi < 8; ++sgi) {
        const float pa = __shfl_xor(sa[sgi], 32), ph = __shfl_xor(sh[sgi], 32);
        HH = sa[sgi] * HH + sh[sgi]; AP *= sa[sgi];
        HH = pa * HH + ph; AP *= pa;
      }
      if (h == 0) {
        const int t0 = m0 + wm * 64;
        const int bb2 = t0 >> 13, chn = (t0 & (SEQ - 1)) >> 6;
        w.SUMA[(bb2 * 128 + chn) * 1024 + c] = AP; w.SUMH[(bb2 * 128 + chn) * 1024 + c] = HH;
      }
    }
    if (l == 0 && bg < 4096) { convert_table_item(p, w, bg); bg += gridDim.x; }
  }
  if (l == 0) for (; bg < 4096; bg += gridDim.x) convert_table_item(p, w, bg);
}
DI void phase_scan1(const WS& w) {
  const float* AA = (const float*)(w.scr + SA_AA); const float* BB = (const float*)(w.scr + SA_BB);
  for (int it = blockIdx.x; it < 1024; it += gridDim.x) {
    const int cg4 = it & 3, ch = (it >> 2) & 127, b = it >> 9;
    const int col = cg4 * 256 + TIDX();
    const size_t base = ((size_t)b * SEQ + ch * 64) * D + col;
    float hh = 0.f, ap = 1.f;
#pragma unroll 8
    for (int s = 0; s < 64; ++s) {
      const float a = AA[base + (size_t)s * D], bv = BB[base + (size_t)s * D];
      hh = a * hh + bv; ap *= a;
    }
    w.SUMA[(b * 128 + ch) * 1024 + col] = ap; w.SUMH[(b * 128 + ch) * 1024 + col] = hh;
  }
}
DI void phase_scan2(const WS& w) {
  const bf16_t* AA = (const bf16_t*)(w.scr + SA_AA); const bf16_t* BB = (const bf16_t*)(w.scr + SA_BB);
  const bf16_t* G = (const bf16_t*)(w.scr + SA_G); bf16_t* YG = (bf16_t*)(w.scr + SA_YG);
  for (int it = blockIdx.x; it < 1024; it += gridDim.x) {
    const int cg4 = it & 3, ch0 = (it >> 2) & 127, b = it >> 9;
    const int ch = b ? (127 - ch0) : ch0;
    const int col = cg4 * 256 + TIDX();
    float hh = 0.f;
    {
      const float* pa = w.SUMA + (size_t)b * 128 * 1024 + col; const float* ph = w.SUMH + (size_t)b * 128 * 1024 + col;
      int c2 = 0;
#pragma unroll 1
      for (; c2 + 16 <= ch; c2 += 16) {
        float sa[16], sh[16];
#pragma unroll
        for (int k = 0; k < 16; ++k) { sa[k] = pa[(c2 + k) * 1024]; sh[k] = ph[(c2 + k) * 1024]; }
#pragma unroll
        for (int k = 0; k < 16; ++k) hh = sa[k] * hh + sh[k];
      }
#pragma unroll 1
      for (; c2 < ch; ++c2) hh = pa[c2 * 1024] * hh + ph[c2 * 1024];
    }
    const size_t base = ((size_t)b * SEQ + ch * 64) * D + col;
#pragma unroll 1
    for (int s0 = 0; s0 < 64; s0 += 16) {
      bf16_t ra[16], rb[16], rg[16];
#pragma unroll
      for (int k = 0; k < 16; ++k) { ra[k] = AA[base + (size_t)(s0 + k) * D]; rb[k] = BB[base + (size_t)(s0 + k) * D]; rg[k] = G[base + (size_t)(s0 + k) * D]; }
#pragma unroll
      for (int k = 0; k < 16; ++k) {
        hh = (1.f - bf2f(ra[k])) * hh + bf2f(rb[k]);
        YG[base + (size_t)(s0 + k) * D] = f2bf(bf2f(rg[k]) * hh);
      }
    }
  }
}
DI void phase_outproj(const Params& p, const WS& w, int l, char* smem, bool dry) {
  int bg = 4096 + blockIdx.x;
  const bf16_t* A = (l < 2) ? (const bf16_t*)(w.scr + SA_YG) : (const bf16_t*)(w.scr + SB_AO);
  const bf16_t* Wt = (l < 2) ? (w.W + W_WOUT + (size_t)l * 1024 * 1024) : (w.W + W_WO + (size_t)(l - 2) * 1024 * 1024);
  for (int it = blockIdx.x; it < 128 * 8 + (int)gridDim.x; it += gridDim.x) {
    int mt, nt;
    if (!xcd_item(it, 8, mt, nt)) break;
    const int m0 = mt * 128, n0 = nt * 128;
    const float* g1 = w.MODS + (l * 2 + (m0 >> 13)) * 6144 + 2048;
    f32x16 acc[2][2];
    gemm_tile(A + (size_t)m0 * D, D, Wt + (size_t)n0 * D, D, D, (bf16_t*)smem, acc);
    EPI_BEGIN
      const size_t o = (size_t)(m0 + trow) * D + n0 + tcol;
      if (!dry) { const float xi = (l == 0) ? p.x[o] : (float)w.X[o]; w.X[o] = (half_t)(xi + g1[n0 + tcol] * val); }
    EPI_END
    if (l == 0 && !dry && bg < 6144) { convert_table_item(p, w, bg); bg += gridDim.x; }
  }
  if (l == 0 && !dry) for (; bg < 6144; bg += gridDim.x) convert_table_item(p, w, bg);
}
DI void phase_peerq(const WS& w, int l, char* smem) {
  const bf16_t* Wt = w.W + W_PQ + (size_t)l * 2048 * 1024;
  for (int it = blockIdx.x; it < 128 * 16; it += gridDim.x) {
    const int mt = it >> 4, nt = it & 15, m0 = mt * 128, n0 = nt * 128;
    f32x16 acc[2][2];
    gemm_tile(w.H + (size_t)m0 * D, D, Wt + (size_t)n0 * D, D, D, (bf16_t*)smem, acc);
    EPI_BEGIN w.QP[(size_t)(m0 + trow) * 2048 + n0 + tcol] = f2bf(val); EPI_END
  }
}
DI float key2f(int k) { unsigned b = (unsigned)(k ^ ((k >> 31) & 0x7fffffff)); return __uint_as_float(b & ~127u); }
DI int key2i(int k) { unsigned b = (unsigned)(k ^ ((k >> 31) & 0x7fffffff)); return (int)(b & 127u); }
DI void phase_topk(const Params& p, const WS& w, int l, char* smem) {
  int bg = 6144 + blockIdx.x;
  int* S = (int*)smem;
  const bf16_t* KB = w.W + W_KEYS + (size_t)l * 262144;
  const bf16_t* PQ = w.W + W_PQ + (size_t)l * 2048 * 1024;
  const int tid = TIDX();
  for (int it = blockIdx.x; it < 1024 + (int)gridDim.x; it += gridDim.x) {
    int mt, hd;
    if (!xcd_item(it, 8, mt, hd)) break;
    const int m0 = mt * 128;
    int L1[16];
#pragma unroll
    for (int q = 0; q < 16; ++q) L1[q] = 0;
#pragma unroll 1
    for (int pp = 0; pp < 2; ++pp) {
      {
        f32x16 acc[2][2];
        {
          f32x16 acc1[2][2];
          gemm_tile(w.H + (size_t)m0 * D, D, PQ + (size_t)(hd * 2 + pp) * 128 * D, D, D, (bf16_t*)smem, acc1);
          bf16_t* sa = (bf16_t*)smem; bf16_t* sb = sa + 2 * 128 * GS;
          const int krow = tid >> 3, kch = tid & 7;
          u32x4 kq0[4], kq1[4];
          {
            const bf16_t* kg = KB + (size_t)(hd * 2 + pp) * 16384;
#pragma unroll
            for (int i2 = 0; i2 < 4; ++i2) {
              kq0[i2] = *(const u32x4*)(kg + (krow + 32 * i2) * 128 + kch * 8);
              kq1[i2] = *(const u32x4*)(kg + (krow + 32 * i2) * 128 + 64 + kch * 8);
            }
          }
          {
            const int _lane = TIDX() & 63, _wave = TIDX() >> 6;
            const int _r = _lane & 31, _h = _lane >> 5, _wm = _wave >> 1, _wn = _wave & 1;
#pragma unroll
            for (int _i = 0; _i < 2; ++_i)
#pragma unroll
              for (int _j = 0; _j < 2; ++_j)
#pragma unroll
                for (int _q = 0; _q < 16; ++_q) {
                  const int trow = _wm * 64 + _i * 32 + (_q & 3) + 8 * (_q >> 2) + 4 * _h;
                  sa[_wn * 128 * GS + trow * GS + _j * 32 + _r] = f2bf(acc1[_i][_j][_q]);
                }
          }
          {
#pragma unroll
            for (int i2 = 0; i2 < 4; ++i2) {
              *(u32x4*)(sb + (krow + 32 * i2) * GS + kch * 8) = kq0[i2];
              *(u32x4*)(sb + 128 * GS + (krow + 32 * i2) * GS + kch * 8) = kq1[i2];
            }
          }
          __syncthreads();
          {
            const f32x16 z = {0.f, 0.f, 0.f, 0.f, 0.f, 0.f, 0.f, 0.f, 0.f, 0.f, 0.f, 0.f, 0.f, 0.f, 0.f, 0.f};
            acc[0][0] = z; acc[0][1] = z; acc[1][0] = z; acc[1][1] = z;
          }
          lds_mma_128(sa, sb, acc);
          lds_mma_128(sa + 128 * GS, sb + 128 * GS, acc);
          __syncthreads();
        }
        EPI_BEGIN
          const unsigned bits = (__float_as_uint(val) & ~127u) | (unsigned)tcol;
          const int key = (int)bits ^ (((int)bits >> 31) & 0x7fffffff);
          S[trow * 128 + (tcol ^ (trow & 31))] = key;
        EPI_END
      }
      __syncthreads();
      const int row = tid & 127, half = tid >> 7;
      int top[16];
      {
        int e[64];
#pragma unroll
        for (int c = 0; c < 64; ++c) e[c] = S[row * 128 + half * 64 + (c ^ (row & 31))];
#pragma unroll
        for (int gb = 0; gb < 64; gb += 16) {
#pragma unroll
          for (int k = 2; k <= 16; k <<= 1) {
#pragma unroll
            for (int j = k >> 1; j > 0; j >>= 1) {
#pragma unroll
              for (int i = 0; i < 16; ++i) {
                const int l2 = i ^ j;
                if (l2 > i) {
                  const bool desc = ((i & k) == 0);
                  const int a = e[gb + i], b = e[gb + l2];
                  const int hi = max(a, b), lo = min(a, b);
                  e[gb + i] = desc ? hi : lo; e[gb + l2] = desc ? lo : hi;
                }
              }
            }
          }
        }
#pragma unroll
        for (int step = 0; step < 3; ++step) {
          const int ga = (step == 1) ? 32 : 0, gbb = (step == 0) ? 16 : ((step == 1) ? 48 : 32);
#pragma unroll
          for (int i = 0; i < 16; ++i) e[ga + i] = max(e[ga + i], e[gbb + 15 - i]);
#pragma unroll
          for (int j = 8; j > 0; j >>= 1) {
#pragma unroll
            for (int i = 0; i < 16; ++i) {
              const int l2 = i ^ j;
              if (l2 > i) {
                const int a = e[ga + i], b = e[ga + l2];
                e[ga + i] = max(a, b); e[ga + l2] = min(a, b);
              }
            }
          }
        }
#pragma unroll
        for (int tt = 0; tt < 16; ++tt) top[tt] = e[tt];
      }
      __syncthreads();
#pragma unroll
      for (int tt = 0; tt < 16; ++tt) S[(row * 2 + half) * 16 + tt] = top[tt];
      __syncthreads();
      if (tid < 128) {
        int m[16]; int pa = 0, pb = 0;
#pragma unroll
        for (int tt = 0; tt < 16; ++tt) {
          const int a = S[(tid * 2) * 16 + pa], b = S[(tid * 2 + 1) * 16 + pb];
          if (a > b) { m[tt] = a; ++pa; } else { m[tt] = b; ++pb; }
        }
        if (pp == 0) {
#pragma unroll
          for (int q = 0; q < 16; ++q) L1[q] = m[q];
        } else {
          int* S2 = S + 4096 + tid * 16;
#pragma unroll
          for (int q = 0; q < 16; ++q) S2[q] = m[q];
          unsigned long long P = 0ull;
          float cv[16]; int ce[16];
#pragma unroll
          for (int tt = 0; tt < 16; ++tt) {
            float best = -3.0e38f; int besta = 0, beste = 0;
#pragma unroll
            for (int a = 0; a <= tt; ++a) {
              const int pa2 = (int)((P >> (4 * a)) & 15ull);
              const int k2 = S2[pa2];
              const float cand = key2f(L1[a]) + key2f(k2);
              if (cand > best) { best = cand; besta = a; beste = key2i(L1[a]) * 128 + key2i(k2); }
            }
            cv[tt] = best; ce[tt] = beste;
            P += 1ull << (4 * besta);
          }
          float sum = 0.f;
          const float cmax = cv[0];
#pragma unroll
          for (int q = 0; q < 16; ++q) { cv[q] = __expf(cv[q] - cmax); sum += cv[q]; }
          const float inv = 1.f / sum;
          int* ip = w.PIDX + ((size_t)(m0 + tid) * 8 + hd) * 16;
          float* gp = w.PG + ((size_t)(m0 + tid) * 8 + hd) * 16;
#pragma unroll
          for (int q = 0; q < 4; ++q) {
            *(int4*)(ip + q * 4) = make_int4(ce[q * 4], ce[q * 4 + 1], ce[q * 4 + 2], ce[q * 4 + 3]);
            *(float4*)(gp + q * 4) = make_float4(cv[q * 4] * inv, cv[q * 4 + 1] * inv, cv[q * 4 + 2] * inv, cv[q * 4 + 3] * inv);
          }
        }
      }
      __syncthreads();
    }
    if (l == 0 && bg < 8192) { convert_table_item(p, w, bg); bg += gridDim.x; }
  }
  if (l == 0) for (; bg < 8192; bg += gridDim.x) convert_table_item(p, w, bg);
}
DI void phase_exp(const Params& p, const WS& w, int l, bool dry) {
  const unsigned char* TU = w.TU + (size_t)l * 16384 * 1024; const unsigned char* TV = w.TV + (size_t)l * 16384 * 1024;
  const float* SU = w.SU + l * 16384; const float* SV = w.SV + l * 16384;
  const int lane = TIDX() & 63, wave = TIDX() >> 6;
  const bool hi5 = (lane & 32) != 0, hi4 = (lane & 16) != 0, hi3 = (lane & 8) != 0;
  const int esel = (lane >> 3) & 7;
  for (int it = blockIdx.x; it < T / 4; it += gridDim.x) {
    const int t = __builtin_amdgcn_readfirstlane(it * 4 + wave);
    const int b = t >> 13;
    int hq[4]; float hs;
    {
      const u32x4* hp = (const u32x4*)(w.H + (size_t)t * D + lane * 16);
      const u32x4 ha = hp[0], hb = hp[1];
      float hv[16];
      hv[0] = bflo(ha.x); hv[1] = bfhi(ha.x); hv[2] = bflo(ha.y); hv[3] = bfhi(ha.y); hv[4] = bflo(ha.z); hv[5] = bfhi(ha.z); hv[6] = bflo(ha.w); hv[7] = bfhi(ha.w);
      hv[8] = bflo(hb.x); hv[9] = bfhi(hb.x); hv[10] = bflo(hb.y); hv[11] = bfhi(hb.y); hv[12] = bflo(hb.z); hv[13] = bfhi(hb.z); hv[14] = bflo(hb.w); hv[15] = bfhi(hb.w);
      float am = 0.f;
#pragma unroll
      for (int q = 0; q < 16; ++q) am = fmaxf(am, fabsf(hv[q]));
#pragma unroll
      for (int o = 32; o > 0; o >>= 1) am = fmaxf(am, __shfl_xor(am, o));
      const float inv = am > 0.f ? 127.f / am : 0.f;
      hs = am * (1.f / 127.f);
#pragma unroll
      for (int q = 0; q < 4; ++q) {
        const int q0 = (int)rintf(hv[q * 4] * inv), q1 = (int)rintf(hv[q * 4 + 1] * inv), q2 = (int)rintf(hv[q * 4 + 2] * inv), q3 = (int)rintf(hv[q * 4 + 3] * inv);
        hq[q] = (int)((unsigned)(q0 & 255) | ((unsigned)(q1 & 255) << 8) | ((unsigned)(q2 & 255) << 16) | ((unsigned)(q3 & 255) << 24));
      }
    }
    const int* ip = w.PIDX + (size_t)t * 128; const float* gp = w.PG + (size_t)t * 128;
    const int mi0 = ip[lane], mi1 = ip[64 + lane]; const float mg0 = gp[lane], mg1 = gp[64 + lane];
    float out[16];
#pragma unroll
    for (int q = 0; q < 16; ++q) out[q] = 0.f;
    float csum = 0.f;
#define EXP_LOAD(P, E0)                                                       \
    {                                                                         \
      const int _mi = ((E0) < 64) ? mi0 : mi1; const float _mg = ((E0) < 64) ? mg0 : mg1; \
      const int _eb = (E0) & 63;                                              \
      _Pragma("unroll") for (int q = 0; q < 8; ++q) {                         \
        const int _id = __builtin_amdgcn_readlane(_mi, _eb + q);              \
        uu##P[q] = *(const u32x4*)(TU + (size_t)_id * 1024 + lane * 16);      \
        vv##P[q] = *(const u32x4*)(TV + (size_t)_id * 1024 + lane * 16);      \
        sv##P[q] = SV[_id];                                                   \
      }                                                                       \
      const int _idsel = __shfl(_mi, _eb + esel);                             \
      gs##P = __shfl(_mg, _eb + esel);                                        \
      su##P = SU[_idsel];                                                     \
    }
#define EXP_COMPUTE(P)                                                        \
    {                                                                         \
      int d[8];                                                               \
      _Pragma("unroll") for (int q = 0; q < 8; ++q) {                         \
        int a0 = __builtin_amdgcn_sdot4((int)uu##P[q].x, hq[0], 0, false);    \
        int a1 = __builtin_amdgcn_sdot4((int)uu##P[q].y, hq[1], 0, false);    \
        a0 = __builtin_amdgcn_sdot4((int)uu##P[q].z, hq[2], a0, false);       \
        a1 = __builtin_amdgcn_sdot4((int)uu##P[q].w, hq[3], a1, false);       \
        d[q] = a0 + a1;                                                       \
      }                                                                       \
      int k4[4];                                                              \
      _Pragma("unroll") for (int q = 0; q < 4; ++q) k4[q] = swap32_sum(d[q], d[4 + q]); \
      int m2[2];                                                              \
      _Pragma("unroll") for (int q = 0; q < 2; ++q) m2[q] = swap16_sum(k4[q], k4[2 + q]); \
      int n1 = (hi3 ? m2[1] : m2[0]) + dpp_mov<0x140>(hi3 ? m2[0] : m2[1]);   \
      n1 += dpp_mov<0xB1>(n1); n1 += dpp_mov<0x4E>(n1); n1 += dpp_mov<0x141>(n1); \
      const float act = (float)n1 * (su##P * hs);                             \
      const float wv = gs##P * gelu_f(act);                                   \
      const int wvi = __builtin_bit_cast(int, wv);                            \
      _Pragma("unroll") for (int q = 0; q < 8; ++q) {                         \
        const float cq = __builtin_bit_cast(float, __builtin_amdgcn_readlane(wvi, 8 * q)) * sv##P[q]; \
        csum += cq;                                                           \
        const unsigned x0 = vv##P[q].x, x1 = vv##P[q].y, x2 = vv##P[q].z, x3 = vv##P[q].w; \
        out[0] += cq * (float)(x0 & 255u); out[1] += cq * (float)((x0 >> 8) & 255u); out[2] += cq * (float)((x0 >> 16) & 255u); out[3] += cq * (float)(x0 >> 24); \
        out[4] += cq * (float)(x1 & 255u); out[5] += cq * (float)((x1 >> 8) & 255u); out[6] += cq * (float)((x1 >> 16) & 255u); out[7] += cq * (float)(x1 >> 24); \
        out[8] += cq * (float)(x2 & 255u); out[9] += cq * (float)((x2 >> 8) & 255u); out[10] += cq * (float)((x2 >> 16) & 255u); out[11] += cq * (float)(x2 >> 24); \
        out[12] += cq * (float)(x3 & 255u); out[13] += cq * (float)((x3 >> 8) & 255u); out[14] += cq * (float)((x3 >> 16) & 255u); out[15] += cq * (float)(x3 >> 24); \
      }                                                                       \
    }
    u32x4 uuA[8], vvA[8], uuB[8], vvB[8]; float svA[8], svB[8]; float gsA, gsB, suA, suB;
    EXP_LOAD(A, 0)
#pragma unroll 1
    for (int e0 = 0; e0 < 128; e0 += 16) {
      EXP_LOAD(B, e0 + 8)
      EXP_COMPUTE(A)
      { const int en = (e0 + 16 < 128) ? (e0 + 16) : 120; EXP_LOAD(A, en) }
      EXP_COMPUTE(B)
    }
#undef EXP_LOAD
#undef EXP_COMPUTE
    if (dry) continue;
    const float* g2 = w.MODS + (l * 2 + b) * 6144 + 5120;
    const int c0 = lane * 16;
    float xn[16]; float ss = 0.f;
#pragma unroll
    for (int i = 0; i < 4; ++i) {
      const uint2 xh = *(const uint2*)(w.X + (size_t)t * D + c0 + i * 4);
      const float4 x0 = make_float4(hlo(xh.x), hhi(xh.x), hlo(xh.y), hhi(xh.y));
      const float4 ga = *(const float4*)(g2 + c0 + i * 4);
      xn[i * 4 + 0] = x0.x + ga.x * (out[i * 4 + 0] - 128.f * csum); xn[i * 4 + 1] = x0.y + ga.y * (out[i * 4 + 1] - 128.f * csum);
      xn[i * 4 + 2] = x0.z + ga.z * (out[i * 4 + 2] - 128.f * csum); xn[i * 4 + 3] = x0.w + ga.w * (out[i * 4 + 3] - 128.f * csum);
    }
#pragma unroll
    for (int q = 0; q < 16; ++q) ss += xn[q] * xn[q];
    ss = wave_sum(ss);
    const float rinv = rsqrtf(ss * (1.f / 1024.f) + 1e-6f);
    if (l == 3) {
#pragma unroll
      for (int i = 0; i < 4; ++i) {
        const float4 ga = *(const float4*)(p.final_g + c0 + i * 4);
        *(float4*)(p.out + (size_t)t * D + c0 + i * 4) = make_float4(xn[i * 4] * rinv * ga.x, xn[i * 4 + 1] * rinv * ga.y, xn[i * 4 + 2] * rinv * ga.z, xn[i * 4 + 3] * rinv * ga.w);
      }
    } else {
      const float* ng = p.norm_mix_g + (l + 1) * 1024;
      const float* nsh = w.MODS + ((l + 1) * 2 + b) * 6144;
      const float* nsc = nsh + 1024;
      float y[16];
#pragma unroll
      for (int i = 0; i < 4; ++i) {
        *(uint2*)(w.X + (size_t)t * D + c0 + i * 4) = make_uint2(packh2(xn[i * 4], xn[i * 4 + 1]), packh2(xn[i * 4 + 2], xn[i * 4 + 3]));
        const float4 ga = *(const float4*)(ng + c0 + i * 4), sc = *(const float4*)(nsc + c0 + i * 4), sh = *(const float4*)(nsh + c0 + i * 4);
        y[i * 4 + 0] = xn[i * 4 + 0] * rinv * ga.x * (1.f + sc.x) + sh.x; y[i * 4 + 1] = xn[i * 4 + 1] * rinv * ga.y * (1.f + sc.y) + sh.y;
        y[i * 4 + 2] = xn[i * 4 + 2] * rinv * ga.z * (1.f + sc.z) + sh.z; y[i * 4 + 3] = xn[i * 4 + 3] * rinv * ga.w * (1.f + sc.w) + sh.w;
      }
      u32x4 o0, o1;
      o0.x = pack2(y[0], y[1]); o0.y = pack2(y[2], y[3]); o0.z = pack2(y[4], y[5]); o0.w = pack2(y[6], y[7]);
      o1.x = pack2(y[8], y[9]); o1.y = pack2(y[10], y[11]); o1.z = pack2(y[12], y[13]); o1.w = pack2(y[14], y[15]);
      *(u32x4*)(w.H + (size_t)t * D + c0) = o0; *(u32x4*)(w.H + (size_t)t * D + c0 + 8) = o1;
      if (l == 1) {
        bf16_t* HKV = (bf16_t*)(w.scr + SB_HKV);
        const float* ksh = w.KVMODS + b * 2048; const float* ksc = ksh + 1024;
#pragma unroll
        for (int i = 0; i < 4; ++i) {
          const float4 ga = *(const float4*)(p.kv_norm_g + c0 + i * 4), sc = *(const float4*)(ksc + c0 + i * 4), sh = *(const float4*)(ksh + c0 + i * 4);
          y[i * 4 + 0] = xn[i * 4 + 0] * rinv * ga.x * (1.f + sc.x) + sh.x; y[i * 4 + 1] = xn[i * 4 + 1] * rinv * ga.y * (1.f + sc.y) + sh.y;
          y[i * 4 + 2] = xn[i * 4 + 2] * rinv * ga.z * (1.f + sc.z) + sh.z; y[i * 4 + 3] = xn[i * 4 + 3] * rinv * ga.w * (1.f + sc.w) + sh.w;
        }
        o0.x = pack2(y[0], y[1]); o0.y = pack2(y[2], y[3]); o0.z = pack2(y[4], y[5]); o0.w = pack2(y[6], y[7]);
        o1.x = pack2(y[8], y[9]); o1.y = pack2(y[10], y[11]); o1.z = pack2(y[12], y[13]); o1.w = pack2(y[14], y[15]);
        *(u32x4*)(HKV + (size_t)t * D + c0) = o0; *(u32x4*)(HKV + (size_t)t * D + c0 + 8) = o1;
      }
    }
  }
}
DI void phase_down(const WS& w, int l, char* smem) {
  float* KVRAW = (float*)(w.scr + SB_KVRAW); float* QLRAW = (float*)(w.scr + SB_QLRAW);
  const bf16_t* HKV = (const bf16_t*)(w.scr + SB_HKV);
  for (int pass = (l == 2) ? 0 : 1; pass < 2; ++pass) {
    const bool kv = (pass == 0);
    const bf16_t* A = kv ? HKV : w.H;
    const bf16_t* Wt = kv ? (w.W + W_DKV) : (w.W + W_DQ + (size_t)(l - 2) * 384 * 1024);
    float* O = kv ? KVRAW : QLRAW;
    for (int it = blockIdx.x; it < 384 + (int)gridDim.x; it += gridDim.x) {
      int mt, nt;
      if (!xcd_item(it, 3, mt, nt)) break;
      const int m0 = mt * 128, n0 = nt * 128;
      f32x16 acc[2][2];
      gemm_tile(A + (size_t)m0 * D, D, Wt + (size_t)n0 * D, D, D, (bf16_t*)smem, acc);
      EPI_BEGIN O[(size_t)(m0 + trow) * 384 + n0 + tcol] = val; EPI_END
    }
  }
}
DI void phase_lnorm(const Params& p, const WS& w, int l) {
  const int lane = TIDX() & 63, wave = TIDX() >> 6;
  const int nkv = (l == 2) ? T / 4 : 0;
  const float* KVRAW = (const float*)(w.scr + SB_KVRAW); const float* QLRAW = (const float*)(w.scr + SB_QLRAW);
  bf16_t* CKV = (bf16_t*)(w.scr + SB_CKV); bf16_t* KR = (bf16_t*)(w.scr + SB_KR); bf16_t* QL = (bf16_t*)(w.scr + SB_QL);
  for (int it0 = blockIdx.x; it0 < nkv + T / 4; it0 += gridDim.x) {
    if (it0 < nkv) {
      const int t = it0 * 4 + wave;
      const float* rr = KVRAW + (size_t)t * 384;
      const float4 v = *(const float4*)(rr + lane * 4);
      float ss = wave_sum(v.x * v.x + v.y * v.y + v.z * v.z + v.w * v.w);
      const float rinv = rsqrtf(ss * (1.f / 256.f) + 1e-6f);
      const float4 gg = *(const float4*)(p.kv_latent_g + lane * 4);
      *(uint2*)(CKV + (size_t)t * 256 + lane * 4) = make_uint2(pack2(v.x * rinv * gg.x, v.y * rinv * gg.y), pack2(v.z * rinv * gg.z, v.w * rinv * gg.w));
      if (lane < 16) {
        const float x1 = rr[256 + lane], x2 = rr[272 + lane];
        const float ang = (float)p.pos[t] * ROPE_FREQ[lane];
        float sn, cs; rope_sincos(ang, sn, cs);
        KR[(size_t)t * 32 + lane] = f2bf(x1 * cs - x2 * sn);
        KR[(size_t)t * 32 + 16 + lane] = f2bf(x1 * sn + x2 * cs);
      }
    } else {
      const int t = (it0 - nkv) * 4 + wave;
      const float* rr = QLRAW + (size_t)t * 384;
      float2 v[3]; float ss = 0.f;
#pragma unroll
      for (int i = 0; i < 3; ++i) { v[i] = *(const float2*)(rr + i * 128 + lane * 2); ss += v[i].x * v[i].x + v[i].y * v[i].y; }
      ss = wave_sum(ss);
      const float rinv = rsqrtf(ss * (1.f / 384.f) + 1e-6f);
      const float* gq = p.q_latent_g + (l - 2) * 384;
#pragma unroll
      for (int i = 0; i < 3; ++i) {
        const int col = i * 128 + lane * 2;
        *(unsigned*)(QL + (size_t)t * 384 + col) = pack2(v[i].x * rinv * gq[col], v[i].y * rinv * gq[col + 1]);
      }
    }
  }
}
DI void phase_up(const WS& w, int l, char* smem) {
  const bf16_t* CKV = (const bf16_t*)(w.scr + SB_CKV); const bf16_t* QL = (const bf16_t*)(w.scr + SB_QL);
  bf16_t* KN = (bf16_t*)(w.scr + SB_KN); bf16_t* VT = (bf16_t*)(w.scr + SB_VT); bf16_t* QM = (bf16_t*)(w.scr + SB_QM);
  const bf16_t* UKV = w.W + W_UKV; const bf16_t* UQ = w.W + W_UQ + (size_t)(l - 2) * 1536 * 384;
  if (l == 2) {
    for (int it = blockIdx.x; it < 2048 + (int)gridDim.x; it += gridDim.x) {
      int mt, nt16;
      if (!xcd_item(it, 16, mt, nt16)) break;
      const int m0 = mt * 128, n0 = (nt16 & 7) * 128;
      f32x16 acc[2][2];
      if (nt16 < 8) {
        gemm_tile(CKV + (size_t)m0 * 256, 256, UKV + (size_t)n0 * 256, 256, 256, (bf16_t*)smem, acc);
        EPI_BEGIN KN[(size_t)(m0 + trow) * D + n0 + tcol] = f2bf(val); EPI_END
      } else {
        gemm_tile(UKV + (size_t)(1024 + n0) * 256, 256, CKV + (size_t)m0 * 256, 256, 256, (bf16_t*)smem, acc);
        const int b = m0 >> 13, s0 = m0 & (SEQ - 1);
        EPI_BEGIN VT[((size_t)b * 1024 + n0 + trow) * SEQ + s0 + tcol] = f2bf(val); EPI_END
      }
    }
  }
  for (int it = blockIdx.x; it < 1536 + (int)gridDim.x; it += gridDim.x) {
    int mt, nt;
    if (!xcd_item(it, 12, mt, nt)) break;
    const int m0 = mt * 128, n0 = nt * 128;
    f32x16 acc[2][2];
    gemm_tile(QL + (size_t)m0 * 384, 384, UQ + (size_t)n0 * 384, 384, 384, (bf16_t*)smem, acc);
    EPI_BEGIN QM[(size_t)(m0 + trow) * 1536 + n0 + tcol] = f2bf(val); EPI_END
  }
}
#define KS_ 104
#define VS_ 72
DI void phase_attn(const Params& p, const WS& w, char* smem) {
  bf16_t* sK = (bf16_t*)smem;
  bf16_t* sV = sK + 2 * 64 * KS_;
  const bf16_t* KN = (const bf16_t*)(w.scr + SB_KN); const bf16_t* VT = (const bf16_t*)(w.scr + SB_VT);
  const bf16_t* KR = (const bf16_t*)(w.scr + SB_KR); const bf16_t* QM = (const bf16_t*)(w.scr + SB_QM);
  bf16_t* AO = (bf16_t*)(w.scr + SB_AO);
  const int tid = TIDX(), lane = tid & 63, wave = tid >> 6, r = lane & 31, h = lane >> 5;
  const int pr = (r & 19) | ((r & 4) << 1) | ((r & 8) >> 1);
  const int G = gridDim.x;
  const float QSC = 0.10206207261596575f * 1.4426950408889634f;
  for (int idx = blockIdx.x; idx < 2048; idx += G) {
    const int rnd = idx / G, jj = idx - rnd * G;
    int qt, bh;
    if (G == 512) {
      const int xcd = jj & 7, slot = jj >> 3;
      bh = xcd + 8 * rnd;
      qt = (rnd & 1) ? slot : (63 - slot);
    } else {
      const int spos = ((rnd & 1) && ((rnd + 1) * G <= 2048)) ? (rnd * G + (G - 1 - jj)) : idx;
      qt = 63 - (spos >> 5); bh = spos & 31;
    }
    const int b = bh >> 4, hd = bh & 15;
    const int q0 = qt * 128, tok0 = b * SEQ;
    const int qrow = tok0 + q0 + wave * 32 + r;
    const int qposi = p.pos[qrow];
    bf16x8 qf[6];
    {
      const bf16_t* qp = QM + (size_t)qrow * 1536 + hd * 96 + h * 8;
      uint4 qr[6];
#pragma unroll
      for (int ks = 0; ks < 6; ++ks) qr[ks] = *(const uint4*)(qp + ks * 16);
#pragma unroll
      for (int ks = 0; ks < 4; ++ks) {
        uint4 o;
        o.x = pack2(bflo(qr[ks].x) * QSC, bfhi(qr[ks].x) * QSC); o.y = pack2(bflo(qr[ks].y) * QSC, bfhi(qr[ks].y) * QSC);
        o.z = pack2(bflo(qr[ks].z) * QSC, bfhi(qr[ks].z) * QSC); o.w = pack2(bflo(qr[ks].w) * QSC, bfhi(qr[ks].w) * QSC);
        qf[ks] = __builtin_bit_cast(bf16x8, o);
      }
      float x1[8], x2[8], o1[8], o2[8];
      x1[0] = bflo(qr[4].x); x1[1] = bfhi(qr[4].x); x1[2] = bflo(qr[4].y); x1[3] = bfhi(qr[4].y);
      x1[4] = bflo(qr[4].z); x1[5] = bfhi(qr[4].z); x1[6] = bflo(qr[4].w); x1[7] = bfhi(qr[4].w);
      x2[0] = bflo(qr[5].x); x2[1] = bfhi(qr[5].x); x2[2] = bflo(qr[5].y); x2[3] = bfhi(qr[5].y);
      x2[4] = bflo(qr[5].z); x2[5] = bfhi(qr[5].z); x2[6] = bflo(qr[5].w); x2[7] = bfhi(qr[5].w);
      const float fpos = (float)qposi;
#pragma unroll
      for (int j = 0; j < 8; ++j) {
        const float ang = fpos * ROPE_FREQ[h * 8 + j];
        float sn, cs; rope_sincos(ang, sn, cs);
        o1[j] = (x1[j] * cs - x2[j] * sn) * QSC; o2[j] = (x1[j] * sn + x2[j] * cs) * QSC;
      }
      uint4 o;
      o.x = pack2(o1[0], o1[1]); o.y = pack2(o1[2], o1[3]); o.z = pack2(o1[4], o1[5]); o.w = pack2(o1[6], o1[7]);
      qf[4] = __builtin_bit_cast(bf16x8, o);
      o.x = pack2(o2[0], o2[1]); o.y = pack2(o2[2], o2[3]); o.z = pack2(o2[4], o2[5]); o.w = pack2(o2[6], o2[7]);
      qf[5] = __builtin_bit_cast(bf16x8, o);
    }
    const int nt = 2 * (qt + 1);
    const int kkey = tid >> 3, kch = tid & 7;
    const int rkey = tid >> 2, rch = tid & 3;
    const bf16_t* gKN = KN + (size_t)(tok0 + kkey) * D + hd * 64 + kch * 8;
    const bf16_t* gKR = KR + (size_t)(tok0 + rkey) * 32 + rch * 8;
    const bf16_t* gVT = VT + ((size_t)bh * 64 + kkey) * SEQ + kch * 8;
    bf16_t* sVV = sK + 2 * 64 * KS_;
    u32x4 Gk0, Gk1, Gr, Gv0, Gv1;
#define ALOAD(KT)                                                            \
    {                                                                        \
      const size_t k1 = (size_t)(KT) * 64;                                   \
      Gk0 = *(const u32x4*)(gKN + k1 * D); Gk1 = *(const u32x4*)(gKN + (k1 + 32) * D); \
      Gr = *(const u32x4*)(gKR + k1 * 32);                                   \
      Gv0 = *(const u32x4*)(gVT + k1); Gv1 = *(const u32x4*)(gVT + (size_t)32 * SEQ + k1); \
    }
#define ASTORE(KB, VB)                                                       \
    {                                                                        \
      bf16_t* nK = sK + (KB) * 64 * KS_; bf16_t* nV = sVV + (VB) * 64 * VS_; \
      *(u32x4*)(nK + kkey * KS_ + kch * 8) = Gk0; *(u32x4*)(nK + (kkey + 32) * KS_ + kch * 8) = Gk1; \
      *(u32x4*)(nK + rkey * KS_ + 64 + rch * 8) = Gr;                        \
      *(u32x4*)(nV + kkey * VS_ + kch * 8) = Gv0; *(u32x4*)(nV + (kkey + 32) * VS_ + kch * 8) = Gv1; \
    }
#define QK_TILE(ST, KB, KT)                                                  \
    {                                                                        \
      const bf16_t* cK = sK + (KB) * 64 * KS_;                               \
      _Pragma("unroll") for (int q = 0; q < 16; ++q) { ST[0][q] = 0.f; ST[1][q] = 0.f; } \
      _Pragma("unroll") for (int kb = 0; kb < 2; ++kb)                       \
      _Pragma("unroll") for (int ks = 0; ks < 6; ++ks) {                     \
        const bf16x8 a = *(const bf16x8*)(cK + (32 * kb + pr) * KS_ + ks * 16 + h * 8); \
        ST[kb] = MFMA(a, qf[ks], ST[kb]);                                    \
      }                                                                      \
      if ((KT) >= nt - 2) {                                                  \
        const int kbase = tok0 + (KT) * 64 + 8 * h;                          \
        _Pragma("unroll") for (int kb = 0; kb < 2; ++kb)                     \
        _Pragma("unroll") for (int g2 = 0; g2 < 2; ++g2) {                   \
          const int4 pa = *(const int4*)(p.pos + kbase + 32 * kb + 16 * g2), pb = *(const int4*)(p.pos + kbase + 32 * kb + 16 * g2 + 4); \
          if (pa.x > qposi) ST[kb][g2 * 8 + 0] = -1e30f; if (pa.y > qposi) ST[kb][g2 * 8 + 1] = -1e30f; \
          if (pa.z > qposi) ST[kb][g2 * 8 + 2] = -1e30f; if (pa.w > qposi) ST[kb][g2 * 8 + 3] = -1e30f; \
          if (pb.x > qposi) ST[kb][g2 * 8 + 4] = -1e30f; if (pb.y > qposi) ST[kb][g2 * 8 + 5] = -1e30f; \
          if (pb.z > qposi) ST[kb][g2 * 8 + 6] = -1e30f; if (pb.w > qposi) ST[kb][g2 * 8 + 7] = -1e30f; \
        }                                                                    \
      }                                                                      \
    }
#define SOFTMAX_PV(ST, VB)                                                   \
    {                                                                        \
      const bf16_t* cV = sVV + (VB) * 64 * VS_;                              \
      float mx = ST[0][0];                                                   \
      _Pragma("unroll") for (int q = 1; q < 16; ++q) mx = fmaxf(mx, ST[0][q]); \
      _Pragma("unroll") for (int q = 0; q < 16; ++q) mx = fmaxf(mx, ST[1][q]); \
      mx = swap32_max(mx);                                    \
      if (__builtin_amdgcn_ballot_w64(mx > mrun + 6.f) != 0ull) {            \
        const float mnew = fmaxf(mrun, mx);                                  \
        const float alpha = __builtin_amdgcn_exp2f(mrun - mnew);             \
        mrun = mnew; lsum *= alpha;                                          \
        _Pragma("unroll") for (int q = 0; q < 16; ++q) { ot[0][q] *= alpha; ot[1][q] *= alpha; } \
      }                                                                      \
      bf16x8 pf[2][2];                                                       \
      _Pragma("unroll") for (int kb = 0; kb < 2; ++kb) {                     \
        float pv[16];                                                        \
        _Pragma("unroll") for (int q = 0; q < 16; ++q) { pv[q] = __builtin_amdgcn_exp2f(ST[kb][q] - mrun); lsum += pv[q]; } \
        _Pragma("unroll") for (int s2 = 0; s2 < 2; ++s2) {                   \
          u32x4 o;                                                           \
          o.x = pack2(pv[8 * s2 + 0], pv[8 * s2 + 1]); o.y = pack2(pv[8 * s2 + 2], pv[8 * s2 + 3]); \
          o.z = pack2(pv[8 * s2 + 4], pv[8 * s2 + 5]); o.w = pack2(pv[8 * s2 + 6], pv[8 * s2 + 7]); \
          pf[kb][s2] = __builtin_bit_cast(bf16x8, o);                        \
        }                                                                    \
      }                                                                      \
      _Pragma("unroll") for (int db = 0; db < 2; ++db)                       \
      _Pragma("unroll") for (int kb = 0; kb < 2; ++kb)                       \
      _Pragma("unroll") for (int s2 = 0; s2 < 2; ++s2) {                     \
        const bf16x8 a = *(const bf16x8*)(cV + (32 * db + r) * VS_ + 32 * kb + 16 * s2 + 8 * h); \
        ot[db] = MFMA(a, pf[kb][s2], ot[db]);                                \
      }                                                                      \
    }
#define FAST_STEP(SC, SN, KB, VB)                                            \
    {                                                                        \
      const bf16_t* cK = sK + (KB) * 64 * KS_;                               \
      const bf16_t* cV = sVV + (VB) * 64 * VS_;                              \
      float mx = SC[0][0];                                                   \
      _Pragma("unroll") for (int q = 1; q < 16; ++q) mx = fmaxf(mx, SC[0][q]); \
      _Pragma("unroll") for (int q = 0; q < 16; ++q) mx = fmaxf(mx, SC[1][q]); \
      mx = swap32_max(mx);                                    \
      if (__builtin_amdgcn_ballot_w64(mx > mrun + 6.f) != 0ull) {            \
        const float mnew = fmaxf(mrun, mx);                                  \
        const float alpha = __builtin_amdgcn_exp2f(mrun - mnew);             \
        mrun = mnew; lsum *= alpha;                                          \
        _Pragma("unroll") for (int q = 0; q < 16; ++q) { ot[0][q] *= alpha; ot[1][q] *= alpha; } \
      }                                                                      \
      _Pragma("unroll") for (int q = 0; q < 16; ++q) { SN[0][q] = 0.f; SN[1][q] = 0.f; } \
      float pv[32];                                                          \
      bf16x8 kf[12];                                                         \
      _Pragma("unroll") for (int st0 = 0; st0 < 3; ++st0) kf[st0] = *(const bf16x8*)(cK + (32 * (st0 & 1) + pr) * KS_ + (st0 >> 1) * 16 + h * 8); \
      __builtin_amdgcn_sched_barrier(0);                                     \
      _Pragma("unroll") for (int step = 0; step < 12; ++step) {              \
        const int kb = step & 1, ks = step >> 1;                             \
        if (step + 3 < 12) kf[step + 3] = *(const bf16x8*)(cK + (32 * ((step + 3) & 1) + pr) * KS_ + ((step + 3) >> 1) * 16 + h * 8); \
        SN[kb] = MFMA(kf[step], qf[ks], SN[kb]);                             \
        const int e0 = (step < 8) ? 3 * step : 24 + 2 * (step - 8);          \
        const int ne = (step < 8) ? 3 : 2;                                   \
        _Pragma("unroll") for (int e = 0; e < 3; ++e) if (e < ne) {          \
          const int ee = e0 + e;                                             \
          pv[ee] = __builtin_amdgcn_exp2f(SC[ee >> 4][ee & 15] - mrun); lsum += pv[ee]; \
        }                                                                    \
        __builtin_amdgcn_sched_barrier(0);                                   \
      }                                                                      \
      _Pragma("unroll") for (int kb = 0; kb < 2; ++kb)                       \
      _Pragma("unroll") for (int s2 = 0; s2 < 2; ++s2) {                     \
        u32x4 o;                                                             \
        const int b0 = kb * 16 + 8 * s2;                                     \
        o.x = pack2(pv[b0 + 0], pv[b0 + 1]); o.y = pack2(pv[b0 + 2], pv[b0 + 3]); \
        o.z = pack2(pv[b0 + 4], pv[b0 + 5]); o.w = pack2(pv[b0 + 6], pv[b0 + 7]); \
        const bf16x8 pfr = __builtin_bit_cast(bf16x8, o);                    \
        _Pragma("unroll") for (int db = 0; db < 2; ++db) {                   \
          const bf16x8 a = *(const bf16x8*)(cV + (32 * db + r) * VS_ + 32 * kb + 16 * s2 + 8 * h); \
          ot[db] = MFMA(a, pfr, ot[db]);                                     \
        }                                                                    \
      }                                                                      \
    }
    const int ntl = nt - 1;
    f32x16 ot[2];
#pragma unroll
    for (int q = 0; q < 16; ++q) { ot[0][q] = 0.f; ot[1][q] = 0.f; }
    float mrun = -1e30f, lsum = 0.f;
    f32x16 stA[2], stB[2];
    ALOAD(0)
    ASTORE(0, 0)
    ALOAD(1)
    __syncthreads();
    QK_TILE(stA, 0, 0)
    ASTORE(1, 1)
    __syncthreads();
    int vb = 0;
    int kt = 0;
    for (; kt + 4 < nt; kt += 2) {
      {
        ALOAD(kt + 2)
        FAST_STEP(stA, stB, 1, vb)
        const int vb2 = (vb == 0) ? 2 : (vb - 1);
        ASTORE(0, vb2)
        __syncthreads();
        vb = (vb == 2) ? 0 : (vb + 1);
      }
      {
        ALOAD(kt + 3)
        FAST_STEP(stB, stA, 0, vb)
        const int vb2 = (vb == 0) ? 2 : (vb - 1);
        ASTORE(1, vb2)
        __syncthreads();
        vb = (vb == 2) ? 0 : (vb + 1);
      }
    }
    for (; kt < nt; kt += 2) {
      {
        const int kn = (kt + 2 < nt) ? (kt + 2) : ntl;
        ALOAD(kn)
        const int k1t = (kt + 1 < nt) ? (kt + 1) : ntl;
        QK_TILE(stB, 1, k1t)
        SOFTMAX_PV(stA, vb)
        const int vb2 = (vb == 0) ? 2 : (vb - 1);
        ASTORE(0, vb2)
        __syncthreads();
        vb = (vb == 2) ? 0 : (vb + 1);
      }
      {
        const int kn = (kt + 3 < nt) ? (kt + 3) : ntl;
        ALOAD(kn)
        const int k1t = (kt + 2 < nt) ? (kt + 2) : ntl;
        QK_TILE(stA, 0, k1t)
        SOFTMAX_PV(stB, vb)
        const int vb2 = (vb == 0) ? 2 : (vb - 1);
        ASTORE(1, vb2)
        __syncthreads();
        vb = (vb == 2) ? 0 : (vb + 1);
      }
    }
#undef ALOAD
#undef ASTORE
#undef QK_TILE
#undef SOFTMAX_PV
#undef FAST_STEP
    lsum += __shfl_xor(lsum, 32);
    const float inv = 1.f / lsum;
    bf16_t* op = AO + (size_t)qrow * D + hd * 64;
#pragma unroll
    for (int db = 0; db < 2; ++db)
#pragma unroll
      for (int g4 = 0; g4 < 4; ++g4) {
        const int d = 32 * db + 8 * g4 + 4 * h;
        *(uint2*)(op + d) = make_uint2(pack2(ot[db][g4 * 4] * inv, ot[db][g4 * 4 + 1] * inv), pack2(ot[db][g4 * 4 + 2] * inv, ot[db][g4 * 4 + 3] * inv));
      }
  }
}


#define XB_TMO      128
#define XB_XCNT(j)  (256  + 64 * (j))
#define XB_XSUB(j)  (1280 + 64 * (j))
#define XB_XGEN(j)  (2304 + 64 * (j))
#define XB_TOP      3328
#define XB_TOPGEN   3392
#define XCD_BAR_WORDS 3456
#define XB_SPIN_CAP (1u << 18)
#define LAS __attribute__((address_space(3)))
DI unsigned xb_ld(unsigned* p) { return __hip_atomic_load(p, __ATOMIC_RELAXED, __HIP_MEMORY_SCOPE_AGENT); }
DI unsigned xb_add(unsigned* p, unsigned v) { return __hip_atomic_fetch_add(p, v, __ATOMIC_RELAXED, __HIP_MEMORY_SCOPE_AGENT); }
DI unsigned xb_xcc_id() { return (unsigned)__builtin_amdgcn_s_getreg((3 << 11) | 20) & 0xFu; }
#define XB_SPIN(cond, bar) do { unsigned _sp = 0; while (cond) { __builtin_amdgcn_s_sleep(1); \
    if ((++_sp & 255u) == 0u) { if (xb_ld(&(bar)[XB_TMO])) break; if (_sp > XB_SPIN_CAP) { atomicAdd(&(bar)[XB_TMO], 1u); break; } } } } while (0)
struct XcdBarrier { unsigned* bar; unsigned x; volatile LAS unsigned* st; };
DI XcdBarrier xcd_barrier_post(unsigned* bar, volatile LAS unsigned* st) {
  XcdBarrier b; b.bar = bar; b.x = xb_xcc_id(); b.st = st;
  if (__builtin_amdgcn_workitem_id_x() == 0) (void)xb_add(&bar[XB_XCNT(b.x)], 1u);
  return b;
}
DI void xcd_barrier_complete(unsigned* bar, unsigned x, unsigned& nloc, unsigned& nx) {
  const unsigned G = gridDim.x;
  unsigned sum, cnt, mine, sp = 0u;
  for (;;) {
    sum = 0u; cnt = 0u; mine = 0u;
#pragma unroll
    for (unsigned j = 0; j < 16; ++j) { const unsigned c = xb_ld(&bar[XB_XCNT(j)]); sum += c; cnt += (c > 0u) ? 1u : 0u; mine = (j == x) ? c : mine; }
    if (sum == G) break;
    __builtin_amdgcn_s_sleep(1);
    if ((++sp & 255u) == 0u) { if (xb_ld(&bar[XB_TMO])) break; if (sp > XB_SPIN_CAP) { atomicAdd(&bar[XB_TMO], 1u); break; } }
  }
  nloc = mine > 0u ? mine : 1u; nx = cnt > 0u ? cnt : 1u;
}
DI void xcd_barrier(const XcdBarrier& b) {
  asm volatile("s_waitcnt vmcnt(0)" ::: "memory");
  __syncthreads();
  if (__builtin_amdgcn_workitem_id_x() == 0) {
    unsigned* bar = b.bar;
    __builtin_amdgcn_s_waitcnt(0);
    unsigned nloc = b.st[0], nx = b.st[1];
    if (nloc == 0u) { xcd_barrier_complete(bar, b.x, nloc, nx); b.st[0] = nloc; b.st[1] = nx; }
    const unsigned old = xb_add(&bar[XB_XSUB(b.x)], 1u);
    const unsigned gen = old / nloc;
    if (old + 1u == (gen + 1u) * nloc) {
      __builtin_amdgcn_fence(__ATOMIC_RELEASE, "agent");
      asm volatile("s_waitcnt vmcnt(0)" ::: "memory");
      const unsigned og = xb_add(&bar[XB_TOP], 1u);
      const unsigned tg = og / nx;
      if (og + 1u == (tg + 1u) * nx) xb_add(&bar[XB_TOPGEN], 1u);
      else XB_SPIN(xb_ld(&bar[XB_TOPGEN]) == tg, bar);
      __builtin_amdgcn_fence(__ATOMIC_ACQUIRE, "agent");
      xb_add(&bar[XB_XGEN(b.x)], 1u);
      asm volatile("s_waitcnt vmcnt(0)" ::: "memory");
    } else {
      XB_SPIN(xb_ld(&bar[XB_XGEN(b.x)]) == gen, bar);
      __builtin_amdgcn_fence(__ATOMIC_ACQUIRE, "agent");
      asm volatile("s_waitcnt vmcnt(0)" ::: "memory");
    }
  }
  __syncthreads();
}

enum { OP_PREP = 0, OP_NORM0, OP_WIN, OP_CONV, OP_GATES, OP_SCAN1, OP_SCAN2, OP_OUTPROJ, OP_FFNNORM, OP_PEERQ, OP_TOPK, OP_EXP,
       OP_DOWN, OP_LNORM, OP_UP, OP_ATTN };
constexpr int NPH = 34;
__device__ const unsigned char PROG[NPH][2] = {
  {OP_PREP, 0}, {OP_NORM0, 0},
  {OP_WIN, 0}, {OP_CONV, 0}, {OP_GATES, 0}, {OP_SCAN2, 0}, {OP_OUTPROJ, 0}, {OP_FFNNORM, 0}, {OP_TOPK, 0}, {OP_EXP, 0},
  {OP_WIN, 1}, {OP_CONV, 1}, {OP_GATES, 1}, {OP_SCAN2, 1}, {OP_OUTPROJ, 1}, {OP_FFNNORM, 1}, {OP_TOPK, 1}, {OP_EXP, 1},
  {OP_DOWN, 2}, {OP_LNORM, 2}, {OP_UP, 2}, {OP_ATTN, 2}, {OP_OUTPROJ, 2}, {OP_FFNNORM, 2}, {OP_TOPK, 2}, {OP_EXP, 2},
  {OP_DOWN, 3}, {OP_LNORM, 3}, {OP_UP, 3}, {OP_ATTN, 3}, {OP_OUTPROJ, 3}, {OP_FFNNORM, 3}, {OP_TOPK, 3}, {OP_EXP, 3}};

template <bool COOP>
__global__ void __launch_bounds__(256, 2) yoco_mega(Params p, int lo, int hi) {
  __shared__ __attribute__((aligned(16))) char smem[SMEM_TOTAL];
  const WS w = make_ws(p.ws);
  if (TIDX() == 0) {
    TJob* sj = (TJob*)(smem + SMEM_MAIN);
#pragma unroll
    for (int q = 0; q < NJOBS; ++q) sj[q] = p.jobs[q];
    *(uint4*)(smem + SMEM_MAIN + 2032) = make_uint4(0u, 0u, 0u, 0u);
  }
  __syncthreads();
  XcdBarrier xb;
  if (COOP) xb = xcd_barrier_post((unsigned*)(p.ws + OFF_BAR), (volatile LAS unsigned*)(smem + SMEM_MAIN + 2032));
  if (COOP && hi > 100000) cg::this_grid().sync();
  for (int ph = lo; ph < hi; ++ph) {
    const int op = PROG[ph][0], l = PROG[ph][1];
    const int nrep = ((REPMASK >> op) & 1) ? 2 : 1;
    for (int rep = 0; rep < nrep; ++rep)
    switch (op) {
      case OP_PREP: if ((OPMASK >> OP_PREP) & 1) { phase_prep(p, w, smem); } break;
      case OP_NORM0: if ((OPMASK >> OP_NORM0) & 1) { phase_norm_rows<false>(p.x, p.norm_mix_g, w.MODS, w.MODS + 1024, 6144, w.H); } break;
      case OP_WIN: if ((OPMASK >> OP_WIN) & 1) { phase_win(p, w, l, smem); } break;
      case OP_CONV: if ((OPMASK >> OP_CONV) & 1) { phase_conv(p, w, l); } break;
      case OP_GATES: if ((OPMASK >> OP_GATES) & 1) { phase_gates(p, w, l, smem); } break;
      case OP_SCAN1: if ((OPMASK >> OP_SCAN1) & 1) { phase_scan1(w); } break;
      case OP_SCAN2: if ((OPMASK >> OP_SCAN2) & 1) { phase_scan2(w); } break;
      case OP_OUTPROJ: if ((OPMASK >> OP_OUTPROJ) & 1) { phase_outproj(p, w, l, smem, rep > 0); } break;
      case OP_FFNNORM: if ((OPMASK >> OP_FFNNORM) & 1) { phase_norm_rows<true>(w.X, p.norm_ffn_g + l * 1024, w.MODS + l * 2 * 6144 + 3072, w.MODS + l * 2 * 6144 + 4096, 6144, w.H); } break;
      case OP_PEERQ: if ((OPMASK >> OP_PEERQ) & 1) { phase_peerq(w, l, smem); } break;
      case OP_TOPK: if ((OPMASK >> OP_TOPK) & 1) { phase_topk(p, w, l, smem); } break;
      case OP_EXP: if ((OPMASK >> OP_EXP) & 1) { phase_exp(p, w, l, rep > 0); } break;
      case OP_DOWN: if ((OPMASK >> OP_DOWN) & 1) { phase_down(w, l, smem); } break;
      case OP_LNORM: if ((OPMASK >> OP_LNORM) & 1) { phase_lnorm(p, w, l); } break;
      case OP_UP: if ((OPMASK >> OP_UP) & 1) { phase_up(w, l, smem); } break;
      case OP_ATTN: if ((OPMASK >> OP_ATTN) & 1) { phase_attn(p, w, smem); } break;
      default: break;
    }
    if (COOP) { if (ph + 1 < hi) { xcd_barrier(xb); for (int q = 0; q < SYNCX; ++q) xcd_barrier(xb); } }
  }
}

static void add_job(Params& P, int& nj, int& tile, const float* src, bf16_t* dst, int K, int N, int ldd, int mode, int rowbase) {
  TJob& j = P.jobs[nj++];
  j.src = src; j.dst = dst; j.K = K; j.N = N; j.ldd = ldd; j.mode = mode; j.rowbase = rowbase; j.tile0 = tile;
  j.ntiles = (K / 64) * ((N + 63) / 64); j.pad = 0; tile += j.ntiles;
}

extern "C" void kernel_launch(void* const* d_in, const int* in_sizes, int n_in, void* d_out, int out_size, void* d_ws, size_t ws_size,
                              hipStream_t stream) {
  static Params P;
  memset(&P, 0, sizeof(P));
  const float* const* f = (const float* const*)d_in;
  P.x = f[0]; P.c = f[1]; P.pos = (const int*)d_in[2];
  P.ada_w = f[3]; P.ada_b = f[4]; P.norm_mix_g = f[5]; P.norm_ffn_g = f[6];
  P.lru_w_in = f[7]; P.lru_conv_w = f[8]; P.lru_conv_b = f[9]; P.lru_wa = f[10]; P.lru_ba = f[11]; P.lru_wx = f[12]; P.lru_bx = f[13];
  P.lru_lambda = f[14]; P.lru_w_out = f[15];
  P.kv_ada_w = f[16]; P.kv_ada_b = f[17]; P.kv_norm_g = f[18]; P.w_dkv = f[19]; P.w_kr = f[20]; P.kv_latent_g = f[21]; P.w_uk = f[22]; P.w_uv = f[23];
  P.w_dq = f[24]; P.q_latent_g = f[25]; P.w_uq = f[26]; P.w_o = f[27];
  P.peer_w_q = f[28]; P.peer_keys = f[29]; P.peer_u = f[30]; P.peer_v = f[31]; P.final_g = f[32];
  P.out = (float*)d_out; P.ws = (char*)d_ws;
  bf16_t* W = (bf16_t*)((char*)d_ws + OFF_W);
  int nj = 0, tile = 0;
  for (int l = 0; l < 2; ++l) add_job(P, nj, tile, P.lru_w_in + (size_t)l * 1024 * 2048, W + W_WIN + (size_t)l * 2048 * 1024, 1024, 2048, 1024, 0, 0);
  for (int l = 0; l < 2; ++l)
    for (int hh = 0; hh < 4; ++hh) {
      add_job(P, nj, tile, P.lru_wa + (size_t)(l * 4 + hh) * 65536, W + W_GATE + (size_t)l * 2048 * 256, 256, 256, 256, 1, hh * 256);
      add_job(P, nj, tile, P.lru_wx + (size_t)(l * 4 + hh) * 65536, W + W_GATE + (size_t)l * 2048 * 256, 256, 256, 256, 2, hh * 256);
    }
  for (int l = 0; l < 2; ++l) add_job(P, nj, tile, P.lru_w_out + (size_t)l * 1024 * 1024, W + W_WOUT + (size_t)l * 1024 * 1024, 1024, 1024, 1024, 0, 0);
  add_job(P, nj, tile, P.w_dkv, W + W_DKV, 1024, 256, 1024, 0, 0);
  add_job(P, nj, tile, P.w_kr, W + W_DKV, 1024, 32, 1024, 0, 256);
  add_job(P, nj, tile, P.w_uk, W + W_UKV, 256, 1024, 256, 0, 0);
  add_job(P, nj, tile, P.w_uv, W + W_UKV, 256, 1024, 256, 0, 1024);
  for (int j = 0; j < 2; ++j) add_job(P, nj, tile, P.w_dq + (size_t)j * 1024 * 384, W + W_DQ + (size_t)j * 384 * 1024, 1024, 384, 1024, 0, 0);
  for (int j = 0; j < 2; ++j) add_job(P, nj, tile, P.w_uq + (size_t)j * 384 * 1536, W + W_UQ + (size_t)j * 1536 * 384, 384, 1536, 384, 0, 0);
  for (int j = 0; j < 2; ++j) add_job(P, nj, tile, P.w_o + (size_t)j * 1024 * 1024, W + W_WO + (size_t)j * 1024 * 1024, 1024, 1024, 1024, 0, 0);
  for (int l = 0; l < 4; ++l) add_job(P, nj, tile, P.peer_w_q + (size_t)l * 1024 * 2048, W + W_PQ + (size_t)l * 2048 * 1024, 1024, 2048, 1024, 0, 0);
  P.n_tconv = tile;
  static int grid_blocks = 0;
  if (!grid_blocks) {
    int dev = 0, cus = 0, per_cu = 0;
    hipGetDevice(&dev);
    hipDeviceGetAttribute(&cus, hipDeviceAttributeMultiprocessorCount, dev);
    hipOccupancyMaxActiveBlocksPerMultiprocessor(&per_cu, yoco_mega<true>, 256, 0);
    if (per_cu > 2) per_cu = 2;
    if (per_cu < 1) per_cu = 1;
    grid_blocks = cus * per_cu;
  }
#if MULTI
  for (int ph = 0; ph < NPH; ++ph) hipLaunchKernelGGL((yoco_mega<false>), dim3(grid_blocks), dim3(256), 0, stream, P, ph, ph + 1);
#else
  int lo = 0, hi = NPH;
  void* args[] = {&P, &lo, &hi};
  (void)hipMemsetAsync((char*)d_ws + OFF_BAR, 0, XCD_BAR_WORDS * 4, stream);
  hipError_t e = hipLaunchCooperativeKernel((void*)yoco_mega<true>, dim3(grid_blocks), dim3(256), args, 0, stream);
  if (e != hipSuccess) fprintf(stderr, "cooperative launch failed: %s (grid %d)\n", hipGetErrorString(e), grid_blocks);
#endif
}
```
